# Optimizing an MI355X kernel written in HIP

```python
import math
import jax, jax.numpy as jnp
from jax import lax
import numpy as np

D_MODEL = 1024
BATCH = 4
SEQ = 8192
DEPTH = 4

N_MIXERS = 3
HEAD_DIM = 64
ROT_DIM = HEAD_DIM // 4
ROPE_THETA = 500000.0
NORM_EPS = 1e-6
D_FF = 4 * D_MODEL

DIFF_HEADS = D_MODEL // (2 * HEAD_DIM)
DIFF_QK_WIDTH = DIFF_HEADS * 2 * HEAD_DIM
DIFF_V_DIM = 2 * HEAD_DIM
DIFF_IN = 2 * DIFF_QK_WIDTH + DIFF_HEADS * DIFF_V_DIM
DENSE_Q_BLOCK = 128

MOBA_HEADS = D_MODEL // HEAD_DIM
MOBA_BLOCK = 256
MOBA_TOPK = 3
MOBA_Q_CHUNK = 32
MOBA_IN = 3 * MOBA_HEADS * HEAD_DIM

SWA_HEADS = D_MODEL // HEAD_DIM
SWA_KV_HEADS = SWA_HEADS // 8
SWA_WINDOW = 128
SWA_Q_BLOCK = SWA_WINDOW
SWA_IN = (SWA_HEADS + 2 * SWA_KV_HEADS) * HEAD_DIM

N_DIFF = (DEPTH + 2) // 3
N_MOBA = (DEPTH + 1) // 3
N_SWA = DEPTH // 3

kernel_name = "hybrid_diff_moba_swa_sink_trunk"


def rms_norm(x, g):
    xf = x.astype(jnp.float32)
    y = xf * lax.rsqrt(jnp.mean(xf * xf, axis=-1, keepdims=True) + NORM_EPS)
    return (y * g.astype(jnp.float32)).astype(x.dtype)


def rope_tables(positions):
    inv = ROPE_THETA ** (-jnp.arange(0, ROT_DIM, 2, dtype=jnp.float32) / ROT_DIM)
    ang = positions.astype(jnp.float32)[..., None] * inv
    return jnp.cos(ang), jnp.sin(ang)


def apply_partial_rope(x, cos, sin):
    half = ROT_DIM // 2
    c = cos[:, :, None, :].astype(x.dtype)
    s = sin[:, :, None, :].astype(x.dtype)
    x1 = x[..., :half]
    x2 = x[..., half:ROT_DIM]
    return jnp.concatenate([x1 * c - x2 * s, x2 * c + x1 * s, x[..., ROT_DIM:]], axis=-1)


def diff_attention(h, w_in, w_out, lam_q1, lam_k1, lam_q2, lam_k2, sub_g, cos, sin, lambda_init):
    B, S, _ = h.shape
    H = DIFF_HEADS
    qkv = h @ w_in
    q, k, v = jnp.split(qkv, [DIFF_QK_WIDTH, 2 * DIFF_QK_WIDTH], axis=-1)
    q = apply_partial_rope(q.reshape(B, S, 2 * H, HEAD_DIM), cos, sin) * (HEAD_DIM ** -0.5)
    k = apply_partial_rope(k.reshape(B, S, 2 * H, HEAD_DIM), cos, sin)
    q = q.reshape(B, S, H, 2, HEAD_DIM)
    k = k.reshape(B, S, H, 2, HEAD_DIM)
    v = v.reshape(B, S, H, DIFF_V_DIM)
    f32 = jnp.float32
    lam = (jnp.exp(jnp.sum(lam_q1.astype(f32) * lam_k1.astype(f32)))
           - jnp.exp(jnp.sum(lam_q2.astype(f32) * lam_k2.astype(f32))) + lambda_init)
    nqb = S // DENSE_Q_BLOCK
    qb = q.reshape(B, nqb, DENSE_Q_BLOCK, H, 2, HEAD_DIM).transpose(1, 0, 2, 3, 4, 5)
    key_pos = jnp.arange(S)

    def block(args):
        qi, blk = args
        q_pos = blk * DENSE_Q_BLOCK + jnp.arange(DENSE_Q_BLOCK)
        s = jnp.einsum('bqhcd,bkhcd->bhcqk', qi, k).astype(f32)
        causal = key_pos[None, :] <= q_pos[:, None]
        s = jnp.where(causal, s, -jnp.inf)
        p = jax.nn.softmax(s, axis=-1)
        p = p[:, :, 0] - lam * p[:, :, 1]
        return jnp.einsum('bhqk,bkhe->bqhe', p.astype(v.dtype), v)

    o = lax.map(block, (qb, jnp.arange(nqb)))
    o = o.transpose(1, 0, 2, 3, 4).reshape(B, S, H, DIFF_V_DIM)
    o = rms_norm(o, sub_g) * (1.0 - lambda_init)
    return o.reshape(B, S, H * DIFF_V_DIM) @ w_out


def moba_attention(h, w_in, w_out, cos, sin):
    B, S, _ = h.shape
    H, D, Bk = MOBA_HEADS, HEAD_DIM, MOBA_BLOCK
    f32 = jnp.float32
    q, k, v = jnp.split(h @ w_in, 3, axis=-1)
    q = apply_partial_rope(q.reshape(B, S, H, D), cos, sin) * (D ** -0.5)
    k = apply_partial_rope(k.reshape(B, S, H, D), cos, sin)
    v = v.reshape(B, S, H, D)
    nb = -(-S // Bk)
    pad = nb * Bk - S
    k = jnp.pad(k, ((0, 0), (0, pad), (0, 0), (0, 0)))
    v = jnp.pad(v, ((0, 0), (0, pad), (0, 0), (0, 0)))
    K = min(MOBA_TOPK, nb)
    kb = k.reshape(B, nb, Bk, H, D).transpose(0, 3, 1, 2, 4)
    vb = v.reshape(B, nb, Bk, H, D).transpose(0, 3, 1, 2, 4)
    k_mean = jnp.mean(kb.astype(f32), axis=3).astype(k.dtype)
    nqc = S // MOBA_Q_CHUNK
    qc = q.reshape(B, nqc, MOBA_Q_CHUNK, H, D).transpose(1, 0, 3, 2, 4)
    b_idx = jnp.arange(B)[:, None, None, None]
    h_idx = jnp.arange(H)[None, :, None, None]
    blk_ids = jnp.arange(nb)
    in_blk = jnp.arange(Bk)

    def chunk(args):
        qi, ci = args
        q_pos = ci * MOBA_Q_CHUNK + jnp.arange(MOBA_Q_CHUNK)
        own = (ci * MOBA_Q_CHUNK) // Bk
        gate = jnp.einsum('bhqd,bhnd->bhqn', qi, k_mean).astype(f32)
        gate = jnp.where(blk_ids < own, gate, -jnp.inf)
        _, sel = lax.top_k(gate, K)
        valid = jnp.arange(K) < own
        ks = kb[b_idx, h_idx, sel]
        vs = vb[b_idx, h_idx, sel]
        s_sel = jnp.einsum('bhqd,bhqnkd->bhqnk', qi, ks).astype(f32)
        s_sel = jnp.where(valid[:, None], s_sel, -jnp.inf).reshape(B, H, MOBA_Q_CHUNK, K * Bk)
        k_own = lax.dynamic_index_in_dim(kb, own, axis=2, keepdims=False)
        v_own = lax.dynamic_index_in_dim(vb, own, axis=2, keepdims=False)
        s_own = jnp.einsum('bhqd,bhkd->bhqk', qi, k_own).astype(f32)
        own_pos = own * Bk + in_blk
        s_own = jnp.where(own_pos[None, :] <= q_pos[:, None], s_own, -jnp.inf)
        p = jax.nn.softmax(jnp.concatenate([s_sel, s_own], axis=-1), axis=-1).astype(v.dtype)
        p_sel = p[..., :K * Bk].reshape(B, H, MOBA_Q_CHUNK, K, Bk)
        p_own = p[..., K * Bk:]
        return (jnp.einsum('bhqnk,bhqnkd->bhqd', p_sel, vs)
                + jnp.einsum('bhqk,bhkd->bhqd', p_own, v_own))

    o = lax.map(chunk, (qc, jnp.arange(nqc)))
    o = o.transpose(1, 0, 3, 2, 4).reshape(B, S, H * D)
    return o @ w_out


def swa_sink_attention(h, w_in, b_in, sinks, w_out, cos, sin):
    B, S, _ = h.shape
    KV, D, Qb = SWA_KV_HEADS, HEAD_DIM, SWA_Q_BLOCK
    G = SWA_HEADS // KV
    f32 = jnp.float32
    qkv = h @ w_in + b_in
    q, k, v = jnp.split(qkv, [SWA_HEADS * D, (SWA_HEADS + KV) * D], axis=-1)
    q = apply_partial_rope(q.reshape(B, S, SWA_HEADS, D), cos, sin) * (D ** -0.5)
    k = apply_partial_rope(k.reshape(B, S, KV, D), cos, sin)
    v = v.reshape(B, S, KV, D)
    nb = S // Qb
    qb = q.reshape(B, nb, Qb, KV, G, D)
    kb = k.reshape(B, nb, Qb, KV, D)
    vb = v.reshape(B, nb, Qb, KV, D)
    pad_k = jnp.zeros_like(kb[:, :1])
    pad_v = jnp.zeros_like(vb[:, :1])
    k2 = jnp.concatenate([jnp.concatenate([pad_k, kb[:, :-1]], axis=1), kb], axis=2)
    v2 = jnp.concatenate([jnp.concatenate([pad_v, vb[:, :-1]], axis=1), vb], axis=2)
    s = jnp.einsum('bnqkgd,bnjkd->bnkgqj', qb, k2).astype(f32)
    qi = jnp.arange(Qb)[:, None] + Qb
    kj = jnp.arange(2 * Qb)[None, :]
    dist = qi - kj
    band = (dist >= 0) & (dist < SWA_WINDOW)
    prev_ok = (jnp.arange(nb)[:, None] > 0) | (jnp.arange(2 * Qb)[None, :] >= Qb)
    mask = band[None, :, :] & prev_ok[:, None, :]
    s = jnp.where(mask[None, :, None, None], s, -jnp.inf)
    sink = sinks.astype(f32).reshape(KV, G)[None, None, :, :, None, None]
    m = jnp.maximum(jnp.max(s, axis=-1, keepdims=True), sink)
    e = jnp.exp(s - m)
    p = (e / (jnp.sum(e, axis=-1, keepdims=True) + jnp.exp(sink - m))).astype(v.dtype)
    o = jnp.einsum('bnkgqj,bnjkd->bnqkgd', p, v2).reshape(B, S, SWA_HEADS * D)
    return o @ w_out


def sqrelu_mlp(h, w_up, w_down):
    a = jnp.maximum(h @ w_up, 0)
    return (a * a) @ w_down


def setup_inputs(seed: int = 0) -> dict:
    key = jax.random.key(seed)
    ks = jax.random.split(key, 24)
    f32 = jnp.float32
    nrm = lambda k, shape, scale: jax.random.normal(k, shape, f32) * scale
    x = jax.random.normal(ks[0], (BATCH, SEQ, D_MODEL), f32)
    positions = jnp.broadcast_to(jnp.arange(SEQ, dtype=jnp.int32)[None, :], (BATCH, SEQ))
    return {
        "x": x,
        "positions": positions,
        "attn_norm_g": 1.0 + nrm(ks[1], (DEPTH, D_MODEL), 0.02),
        "mlp_norm_g": 1.0 + nrm(ks[2], (DEPTH, D_MODEL), 0.02),
        "diff_w_in": nrm(ks[3], (N_DIFF, D_MODEL, DIFF_IN), D_MODEL ** -0.5),
        "diff_w_out": nrm(ks[4], (N_DIFF, DIFF_HEADS * DIFF_V_DIM, D_MODEL), (DIFF_HEADS * DIFF_V_DIM) ** -0.5),
        "diff_lam_q1": nrm(ks[5], (N_DIFF, HEAD_DIM), 0.1),
        "diff_lam_k1": nrm(ks[6], (N_DIFF, HEAD_DIM), 0.1),
        "diff_lam_q2": nrm(ks[7], (N_DIFF, HEAD_DIM), 0.1),
        "diff_lam_k2": nrm(ks[8], (N_DIFF, HEAD_DIM), 0.1),
        "diff_subln_g": 1.0 + nrm(ks[9], (N_DIFF, DIFF_V_DIM), 0.02),
        "moba_w_in": nrm(ks[10], (N_MOBA, D_MODEL, MOBA_IN), D_MODEL ** -0.5),
        "moba_w_out": nrm(ks[11], (N_MOBA, MOBA_HEADS * HEAD_DIM, D_MODEL), (MOBA_HEADS * HEAD_DIM) ** -0.5),
        "swa_w_in": nrm(ks[12], (N_SWA, D_MODEL, SWA_IN), D_MODEL ** -0.5),
        "swa_b_in": nrm(ks[13], (N_SWA, SWA_IN), 0.02),
        "swa_sinks": nrm(ks[14], (N_SWA, SWA_HEADS), 0.5),
        "swa_w_out": nrm(ks[15], (N_SWA, SWA_HEADS * HEAD_DIM, D_MODEL), (SWA_HEADS * HEAD_DIM) ** -0.5),
        "mlp_w_up": nrm(ks[16], (DEPTH, D_MODEL, D_FF), D_MODEL ** -0.5),
        "mlp_w_down": nrm(ks[17], (DEPTH, D_FF, D_MODEL), 0.5 * D_FF ** -0.5),
        "final_norm_g": 1.0 + nrm(ks[18], (D_MODEL,), 0.02),
    }


def reference(x, positions, attn_norm_g, mlp_norm_g, diff_w_in, diff_w_out, diff_lam_q1, diff_lam_k1,
              diff_lam_q2, diff_lam_k2, diff_subln_g, moba_w_in, moba_w_out, swa_w_in, swa_b_in,
              swa_sinks, swa_w_out, mlp_w_up, mlp_w_down, final_norm_g):
    cos, sin = rope_tables(positions)
    h = x
    for i in range(DEPTH):
        mixer = i % N_MIXERS
        slot = i // N_MIXERS
        a = rms_norm(h, attn_norm_g[i])
        if mixer == 0:
            lambda_init = 0.8 - 0.6 * math.exp(-0.3 * i)
            y = diff_attention(a, diff_w_in[slot], diff_w_out[slot], diff_lam_q1[slot], diff_lam_k1[slot],
                               diff_lam_q2[slot], diff_lam_k2[slot], diff_subln_g[slot], cos, sin, lambda_init)
        elif mixer == 1:
            y = moba_attention(a, moba_w_in[slot], moba_w_out[slot], cos, sin)
        else:
            y = swa_sink_attention(a, swa_w_in[slot], swa_b_in[slot], swa_sinks[slot], swa_w_out[slot], cos, sin)
        h = h + y
        h = h + sqrelu_mlp(rms_norm(h, mlp_norm_g[i]), mlp_w_up[i], mlp_w_down[i])
    return rms_norm(h, final_norm_g)
```

```cpp
#include <hip/hip_runtime.h>
#include <hip/hip_cooperative_groups.h>
#include <hip/hip_bf16.h>
#include <cstdio>
#include <cstdint>
#include <cmath>
namespace cg = cooperative_groups;
namespace pg8 {
#define PG8_LAS __attribute__((address_space(3)))
typedef unsigned short bf16_t;
typedef short bf16x8 __attribute__((ext_vector_type(8)));
typedef float f32x4 __attribute__((ext_vector_type(4)));
typedef unsigned u32x4 __attribute__((ext_vector_type(4)));
constexpr int BM = 256, BK = 64, HALF = 128, HTB = HALF * BK * 2  , STAGE_BYTES = 8 * HTB, NXCD = 8, WGM = 8;

__host__ __device__ __forceinline__ int lds_byte(int r, int c) { const int st = (r >> 4) * 2 + (c >> 5), rr = r & 15, cc = c & 31, ob = rr * 64 + cc * 2; return st * 1024 + (ob ^ (((ob >> 9) & 1) << 5)); }
__host__ __device__ __forceinline__ void stage_rc(int b, int& R, int& C) { const int st = b / 1024, sb = b % 1024, swz = sb ^ (((sb >> 9) & 1) << 5); R = (st >> 1) * 16 + swz / 64; C = (st & 1) * 32 + (swz % 64) / 2; }
__host__ __device__ __forceinline__ int perm32(int rho) { const int n = rho >> 4, i = rho & 15; return 8 * (i >> 2) + 4 * n + (i & 3); }

struct Unit { int pm, pn; };
struct Gemm { const bf16_t* A; const bf16_t* Bt; int M, N, K; };

struct StaticOrder {
    int nM, nN, nwg, G, c;
    __host__ __device__ void init(int M, int N, int G_, int c_) { nM = M / BM; nN = N / BM; nwg = nM * nN; G = G_; c = c_; }
    __host__ __device__ bool next(int i, Unit& u) const {
        const long L = (long)i * G + c; if (L >= nwg) return false;
        int wgid = (int)L; { const int q = nwg / NXCD, r = nwg % NXCD, xcd = wgid % NXCD, off = wgid / NXCD; wgid = (xcd < r ? xcd * (q + 1) : r * (q + 1) + (xcd - r) * q) + off; }
        const int nig = WGM * nN, gid = wgid / nig, fm = gid * WGM, gsz = (nM - fm) < WGM ? (nM - fm) : WGM;
        u.pm = fm + ((wgid % nig) % gsz); u.pn = (wgid % nig) / gsz; return true;
    }
    __device__ __forceinline__ void a_ready(const Unit&) const {}
    __device__ __forceinline__ void done(const Unit&) const {}
};

__device__ __forceinline__ unsigned cvt_pk_bf16(float lo, float hi) { unsigned r; asm volatile("v_cvt_pk_bf16_f32 %0, %1, %2" : "=v"(r) : "v"(lo), "v"(hi)); return r; }
typedef float f32x2 __attribute__((ext_vector_type(2)));
__device__ __forceinline__ f32x2 gelu_pk(f32x2 v) {
    const f32x2 av = __builtin_elementwise_abs(v), d = av * 0.2316418882f + 1.0f;
    f32x2 t; t.x = __builtin_amdgcn_rcpf(d.x); t.y = __builtin_amdgcn_rcpf(d.y);
    f32x2 q = t * 0.5307027145f + (-0.7265760135f); q = q * t + 0.7107068705f; q = q * t + (-0.142248368f); q = q * t + 0.127414796f; q = q * t;
    const f32x2 s = (v * v) * (-0.72134752044f);
    f32x2 e; e.x = __builtin_amdgcn_exp2f(s.x); e.y = __builtin_amdgcn_exp2f(s.y);
    const f32x2 m = v * (q * e), r = v - m;
    f32x2 o; o.x = v.x < 0.f ? m.x : r.x; o.y = v.y < 0.f ? m.y : r.y; return o;
}

template <int ACT  > struct EpiBf16 {
    static constexpr bool PERM = true, AFTER_DRAIN = false; static_assert(ACT == 0 || ACT == 1, "EpiBf16: ACT is 0 (none) or 1 (gelu_pk)");
    bf16_t* O; int ldc; const float* bias; int split_cols; size_t split_stride; float scale0;
    __device__ __forceinline__ void operator()(const f32x4 (&acc)[2][2][4][2], const Unit& u, int wr, int wc, int fr, int fq) const {
        const int row0 = u.pm * BM + wr * 64 + fr; int colt = u.pn * BM; bf16_t* base = O;
        float sc = 1.f; if (split_cols) { const int t = colt / split_cols; base += (size_t)t * split_stride; colt -= t * split_cols; if (t == 0) sc = scale0; }
        const int col0 = colt + wc * 32 + 8 * fq, bcol0 = u.pn * BM + wc * 32 + 8 * fq;
        f32x4 bv[2][2];
#pragma unroll
        for (int bj = 0; bj < 2; ++bj)
#pragma unroll
            for (int n = 0; n < 2; ++n) bv[bj][n] = bias ? *(const f32x4*)(bias + bcol0 + bj * HALF + 4 * n) : (f32x4){0.f, 0.f, 0.f, 0.f};
#pragma unroll
        for (int ai = 0; ai < 2; ++ai)
#pragma unroll
            for (int m = 0; m < 4; ++m) { bf16_t* rowp = base + (size_t)(row0 + ai * HALF + m * 16) * ldc + col0;
#pragma unroll
                for (int bj = 0; bj < 2; ++bj) { f32x4 v0 = acc[ai][bj][m][0] + bv[bj][0], v1 = acc[ai][bj][m][1] + bv[bj][1];
                    if (ACT == 1) { f32x2 a = gelu_pk((f32x2){v0[0], v0[1]}), b = gelu_pk((f32x2){v0[2], v0[3]}), c = gelu_pk((f32x2){v1[0], v1[1]}), d = gelu_pk((f32x2){v1[2], v1[3]});
                        v0 = (f32x4){a.x, a.y, b.x, b.y}; v1 = (f32x4){c.x, c.y, d.x, d.y}; }
                    v0 = v0 * sc; v1 = v1 * sc; u32x4 w; w.x = cvt_pk_bf16(v0[0], v0[1]); w.y = cvt_pk_bf16(v0[2], v0[3]); w.z = cvt_pk_bf16(v1[0], v1[1]); w.w = cvt_pk_bf16(v1[2], v1[3]);
                    *(u32x4*)(rowp + bj * HALF) = w; } }
    }
};

__device__ __forceinline__ float xrow16_sum(float x) {
    auto s = __builtin_amdgcn_permlane16_swap(__float_as_uint(x), __float_as_uint(x), false, false);
    x = __uint_as_float(s[0]) + __uint_as_float(s[1]);
    auto t = __builtin_amdgcn_permlane32_swap(__float_as_uint(x), __float_as_uint(x), false, false);
    return __uint_as_float(t[0]) + __uint_as_float(t[1]);
}
__device__ __forceinline__ float xor16(float x) {
    auto s = __builtin_amdgcn_permlane16_swap(__float_as_uint(x), __float_as_uint(x), false, false);
    return __uint_as_float(s[0] ^ s[1] ^ __float_as_uint(x));
}
template <int NR> __device__ __forceinline__ void row_rstd(float (&rstd)[NR], const float* rsq, int rowb, int fq) {
    f32x4 q[NR];
#pragma unroll
    for (int i = 0; i < NR; ++i) q[i] = *(const f32x4*)(rsq + (size_t)(rowb + i * 16) * 16 + fq * 4);
#pragma unroll
    for (int i = 0; i < NR; ++i) { const float t = xrow16_sum((q[i][0] + q[i][1]) + (q[i][2] + q[i][3])); rstd[i] = __builtin_amdgcn_rsqf(t * (1.0f / 1024.0f) + 1e-6f); }
}
__device__ __forceinline__ u32x4 dpp_xor1(u32x4 v) { u32x4 r;
#pragma unroll
    for (int e = 0; e < 4; ++e) r[e] = (unsigned)__builtin_amdgcn_mov_dpp((int)v[e], 0xB1, 0xf, 0xf, true);
    return r; }
struct EpiQKV {
    static constexpr bool PERM = true, AFTER_DRAIN = false, WIDE = true;
    bf16_t* O; int ldc; const float* bias; const float* rope; int rope_cols, q_cols; float qscale; const float* rsq;
    __device__ __forceinline__ void operator()(const f32x4 (&acc)[2][2][4][2], const Unit& u, int wr, int wc, int fr, int fq) const {
        const int row0 = u.pm * BM + wr * 64 + fr, odd = fr & 1;
        const int colw = u.pn * BM + wc * 64;
        const bool do_rope = colw < rope_cols;
        const bool rl = do_rope && (fq < 2);
        const float sgn = (fq == 0) ? -1.f : 1.f;
        const float sc = (colw < q_cols) ? qscale : 1.f;
        f32x4 bv[2][2];
#pragma unroll
        for (int bj = 0; bj < 2; ++bj) { const int col0 = colw + bj * 32 + 8 * fq;
            bv[bj][0] = bias ? *(const f32x4*)(bias + col0) : (f32x4){0.f, 0.f, 0.f, 0.f}; bv[bj][1] = bias ? *(const f32x4*)(bias + col0 + 4) : (f32x4){0.f, 0.f, 0.f, 0.f}; }
        const int colA = colw + odd * 32 + 8 * fq;
        float rstd[2][4]; row_rstd<4>(rstd[0], rsq, row0, fq); row_rstd<4>(rstd[1], rsq, row0 + HALF, fq);
        f32x4 cs[8][4];
#define EPIQKV_LOAD(k_) do { \
            cs[k_][0] = (f32x4){1.f, 1.f, 1.f, 1.f}; cs[k_][1] = cs[k_][0]; cs[k_][2] = (f32x4){0.f, 0.f, 0.f, 0.f}; cs[k_][3] = cs[k_][2]; \
            if (rl) { const f32x4* rp = (const f32x4*)(rope + (size_t)(row0 + ((k_) >> 2) * HALF + ((k_) & 3) * 16) * 16); cs[k_][0] = rp[0]; cs[k_][1] = rp[1]; cs[k_][2] = rp[2]; cs[k_][3] = rp[3]; } } while (0)
        EPIQKV_LOAD(0);
#pragma unroll
        for (int k = 0; k < 8; ++k) { const int ai = k >> 2, m = k & 3;
            if (k + 1 < 8) EPIQKV_LOAD(k + 1);
            const int row = row0 + ai * HALF + m * 16;
            u32x4 w[2];
#pragma unroll
            for (int bj = 0; bj < 2; ++bj) {
                f32x4 v0 = acc[ai][bj][m][0] * rstd[ai][m] + bv[bj][0], v1 = acc[ai][bj][m][1] * rstd[ai][m] + bv[bj][1];
                if (bj == 0 && do_rope) {
                    f32x4 p0, p1;
#pragma unroll
                    for (int e = 0; e < 4; ++e) { p0[e] = xor16(v0[e]); p1[e] = xor16(v1[e]); }
                    if (rl) { v0 = v0 * cs[k][0] + (p0 * cs[k][2]) * sgn; v1 = v1 * cs[k][1] + (p1 * cs[k][3]) * sgn; }
                }
                v0 = v0 * sc; v1 = v1 * sc;
                w[bj].x = cvt_pk_bf16(v0[0], v0[1]); w[bj].y = cvt_pk_bf16(v0[2], v0[3]); w[bj].z = cvt_pk_bf16(v1[0], v1[1]); w[bj].w = cvt_pk_bf16(v1[2], v1[3]);
            }
            const u32x4 rcv = dpp_xor1(odd ? w[0] : w[1]);
            const u32x4 s1 = odd ? rcv : w[0], s2 = odd ? w[1] : rcv;
            bf16_t* rp = O + (size_t)(row - odd) * ldc + colA;
            *(u32x4*)rp = s1; *(u32x4*)(rp + ldc) = s2;
        }
#undef EPIQKV_LOAD
    }
};
struct EpiRelu2 {
    static constexpr bool PERM = true, AFTER_DRAIN = false, WIDE = true;
    bf16_t* O; int ldc; const float* rsq;
    __device__ __forceinline__ void operator()(const f32x4 (&acc)[2][2][4][2], const Unit& u, int wr, int wc, int fr, int fq) const {
        const int row0 = u.pm * BM + wr * 64 + fr, odd = fr & 1;
        const int colA = u.pn * BM + wc * 64 + odd * 32 + 8 * fq;
        float rstd[2][4]; row_rstd<4>(rstd[0], rsq, row0, fq); row_rstd<4>(rstd[1], rsq, row0 + HALF, fq);
#pragma unroll
        for (int ai = 0; ai < 2; ++ai) {
#pragma unroll
            for (int m = 0; m < 4; ++m) { const int row = row0 + ai * HALF + m * 16;
                u32x4 w[2];
#pragma unroll
                for (int bj = 0; bj < 2; ++bj) { f32x4 v0 = acc[ai][bj][m][0] * rstd[ai][m], v1 = acc[ai][bj][m][1] * rstd[ai][m];
#pragma unroll
                    for (int e = 0; e < 4; ++e) { const float a = fmaxf(v0[e], 0.f), b = fmaxf(v1[e], 0.f); v0[e] = a * a; v1[e] = b * b; }
                    w[bj].x = cvt_pk_bf16(v0[0], v0[1]); w[bj].y = cvt_pk_bf16(v0[2], v0[3]); w[bj].z = cvt_pk_bf16(v1[0], v1[1]); w[bj].w = cvt_pk_bf16(v1[2], v1[3]); }
                u32x4 snd, rcv;
#pragma unroll
                for (int e = 0; e < 4; ++e) { snd[e] = odd ? w[0][e] : w[1][e]; rcv[e] = (unsigned)__builtin_amdgcn_mov_dpp((int)snd[e], 0xB1, 0xf, 0xf, true); }
                u32x4 s1, s2;
#pragma unroll
                for (int e = 0; e < 4; ++e) { s1[e] = odd ? rcv[e] : w[0][e]; s2[e] = odd ? w[1][e] : rcv[e]; }
                bf16_t* rp = O + (size_t)(row - odd) * ldc + colA;
                *(u32x4*)rp = s1; *(u32x4*)(rp + ldc) = s2; } }
    }
};
template <bool F32BASE> struct EpiRes {
    static constexpr bool PERM = true, AFTER_DRAIN = false, WIDE = true;
    const float* basef; bf16_t* hb; int ldc; float* rsq;
    __device__ __forceinline__ void operator()(const f32x4 (&acc)[2][2][4][2], const Unit& u, int wr, int wc, int fr, int fq) const {
        const int row0 = u.pm * BM + wr * 64 + fr, odd = fr & 1;
        const int colw = u.pn * BM + wc * 64, colA = colw + odd * 32 + 8 * fq;
        f32x4 bf[F32BASE ? 4 : 1][2][2][2]; u32x4 bb[F32BASE ? 1 : 4][2][2];
#define EPIRES_LOAD(am_) do { _Pragma("unroll") for (int mi = 0; mi < 2; ++mi) { const int row_ = row0 + ((am_) >> 1) * HALF + (((am_) & 1) * 2 + mi) * 16; \
            if (F32BASE) { _Pragma("unroll") for (int bj = 0; bj < 2; ++bj) { const float* p_ = basef + (size_t)row_ * ldc + colw + bj * 32 + 8 * fq; bf[F32BASE ? (am_) : 0][mi][bj][0] = *(const f32x4*)p_; bf[F32BASE ? (am_) : 0][mi][bj][1] = *(const f32x4*)(p_ + 4); } } \
            else { const bf16_t* p_ = hb + (size_t)(row_ - odd) * ldc + colA; bb[F32BASE ? 0 : (am_)][mi][0] = *(const u32x4*)p_; bb[F32BASE ? 0 : (am_)][mi][1] = *(const u32x4*)(p_ + ldc); } } } while (0)
        EPIRES_LOAD(0);
#pragma unroll
        for (int am = 0; am < 4; ++am) { const int ai = am >> 1;
            if (am + 1 < 4) EPIRES_LOAD(am + 1);
#pragma unroll
            for (int mi = 0; mi < 2; ++mi) { const int m = (am & 1) * 2 + mi; const int row = row0 + ai * HALF + m * 16; float ss = 0.f;
                u32x4 own[2];
                if (!F32BASE) { const u32x4 l1 = bb[F32BASE ? 0 : am][mi][0], l2 = bb[F32BASE ? 0 : am][mi][1]; const u32x4 rcv = dpp_xor1(odd ? l1 : l2); own[0] = odd ? rcv : l1; own[1] = odd ? l2 : rcv; }
                u32x4 w[2];
#pragma unroll
                for (int bj = 0; bj < 2; ++bj) {
                    f32x4 b0, b1;
                    if (F32BASE) { b0 = bf[F32BASE ? am : 0][mi][bj][0]; b1 = bf[F32BASE ? am : 0][mi][bj][1]; }
                    else { const u32x4 q = own[bj];
                        b0 = (f32x4){__uint_as_float(q.x << 16), __uint_as_float(q.x & 0xffff0000u), __uint_as_float(q.y << 16), __uint_as_float(q.y & 0xffff0000u)};
                        b1 = (f32x4){__uint_as_float(q.z << 16), __uint_as_float(q.z & 0xffff0000u), __uint_as_float(q.w << 16), __uint_as_float(q.w & 0xffff0000u)}; }
                    const f32x4 v0 = b0 + acc[ai][bj][m][0], v1 = b1 + acc[ai][bj][m][1];
                    ss += ((v0[0] * v0[0] + v0[1] * v0[1]) + (v0[2] * v0[2] + v0[3] * v0[3])) + ((v1[0] * v1[0] + v1[1] * v1[1]) + (v1[2] * v1[2] + v1[3] * v1[3]));
                    w[bj].x = cvt_pk_bf16(v0[0], v0[1]); w[bj].y = cvt_pk_bf16(v0[2], v0[3]); w[bj].z = cvt_pk_bf16(v1[0], v1[1]); w[bj].w = cvt_pk_bf16(v1[2], v1[3]); }
                const u32x4 rcv2 = dpp_xor1(odd ? w[0] : w[1]);
                const u32x4 s1 = odd ? rcv2 : w[0], s2 = odd ? w[1] : rcv2;
                bf16_t* rp = hb + (size_t)(row - odd) * ldc + colA;
                *(u32x4*)rp = s1; *(u32x4*)(rp + ldc) = s2;
                ss = xrow16_sum(ss);
                if (fq == 0) rsq[(size_t)row * 16 + u.pn * 4 + wc] = ss; }
        }
#undef EPIRES_LOAD
    }
};
template <class Epi, class Sched, bool ALIGN_EPI = false, bool SP2 = false>
__device__ __forceinline__ void gemm_phase(PG8_LAS unsigned char* lds, const Gemm g, const Sched& S, const Epi& E) {
    int tid_ = threadIdx.x; asm volatile("" : "+v"(tid_));
    const int tid = tid_, wid = __builtin_amdgcn_readfirstlane(tid >> 6), lane = tid & 63, wr = wid >> 2, wc = wid & 3, fr = lane & 15, fq = lane >> 4;
    const int K = g.K, nt = K / BK;
    unsigned voffA[2], voffB[2];
#pragma unroll
    for (int i = 0; i < 2; ++i) { int R, C; stage_rc(tid * 16 + i * 8192, R, C); const int Rb = Epi::WIDE ? (64 * (R >> 5) + perm32(R & 31)) : (Epi::PERM ? ((R & ~31) + perm32(R & 31)) : R);
        voffA[i] = (unsigned)(R * K + C) * 2u; voffB[i] = (unsigned)(Rb * K + C) * 2u; }
    const size_t kstep = (size_t)(BK * 2);
    const size_t hstep = (size_t)HALF * K * 2;
    const size_t hstepB = Epi::WIDE ? (size_t)32 * K * 2 : hstep;
    const size_t tstep = 2 * hstep;
    const unsigned ldsw = (unsigned)wid * 1024u;
    const int aoff = lds_byte(wr * 64 + fr, fq * 8), boff = lds_byte(wc * 32 + fr, fq * 8);
#define PG8_SA(b, h) (((b) * 2 + (h)) * HTB)
#define PG8_SB(b, h) ((4 + (b) * 2 + (h)) * HTB)
#define PG8_STAGE(bufoff, gbase, voff) do { _Pragma("unroll") for (int _i = 0; _i < 2; ++_i) \
        __builtin_amdgcn_global_load_lds((const unsigned*)((const char*)(gbase) + (voff)[_i]), (PG8_LAS unsigned*)(lds + (bufoff) + ldsw + _i * 8192), 16, 0, 0); } while (0)
#define PG8_LDA(dst, b, h) do { _Pragma("unroll") for (int m = 0; m < 4; ++m) _Pragma("unroll") for (int k = 0; k < 2; ++k) dst[m][k] = *(const PG8_LAS bf16x8*)(lds + PG8_SA(b, h) + aoff + m * 2048 + k * 1024); } while (0)
#define PG8_LDB(dst, b, h) do { _Pragma("unroll") for (int n = 0; n < 2; ++n) _Pragma("unroll") for (int k = 0; k < 2; ++k) dst[n][k] = *(const PG8_LAS bf16x8*)(lds + PG8_SB(b, h) + boff + n * 2048 + k * 1024); } while (0)
#define PG8_MMA(ai, bj, At, Bt) do { __builtin_amdgcn_s_setprio(1); _Pragma("unroll") for (int m = 0; m < 4; ++m) _Pragma("unroll") for (int n = 0; n < 2; ++n) _Pragma("unroll") for (int k = 0; k < 2; ++k) \
        acc[ai][bj][m][n] = __builtin_amdgcn_mfma_f32_16x16x32_bf16(Bt[n][k], At[m][k], acc[ai][bj][m][n], 0, 0, 0); __builtin_amdgcn_s_setprio(0); } while (0)
#define PG8_WAIT_V(n) asm volatile("s_waitcnt vmcnt(" #n ")" ::: "memory")
#define PG8_WAIT_L(n) asm volatile("s_waitcnt lgkmcnt(" #n ")" ::: "memory")
#define PG8_BAR __builtin_amdgcn_s_barrier()
#define PG8_SCHED __builtin_amdgcn_sched_barrier(0)
    Unit cur, nxt; int ui = 0;
    if (!S.next(0, cur)) return;
    f32x4 acc[2][2][4][2];
#pragma unroll
    for (int a = 0; a < 2; ++a)
#pragma unroll
        for (int b = 0; b < 2; ++b)
#pragma unroll
            for (int m = 0; m < 4; ++m)
#pragma unroll
                for (int n = 0; n < 2; ++n) acc[a][b][m][n] = (f32x4){0.f, 0.f, 0.f, 0.f};
    bf16x8 At[4][2], B0[2][2], B1[2][2];
    const char* cA = (const char*)g.A + (size_t)cur.pm * tstep; const char* cB = (const char*)g.Bt + (size_t)cur.pn * tstep;
    S.a_ready(cur);
    if constexpr (SP2) {
        PG8_STAGE(PG8_SB(0, 0), cB, voffB); PG8_STAGE(PG8_SB(0, 1), cB + hstepB, voffB); PG8_STAGE(PG8_SA(0, 0), cA, voffA); PG8_STAGE(PG8_SA(0, 1), cA + hstep, voffA);
        if (wr == 1) PG8_BAR;
        PG8_WAIT_V(2); PG8_BAR;
        PG8_STAGE(PG8_SB(1, 0), cB + kstep, voffB); PG8_STAGE(PG8_SA(1, 0), cA + kstep, voffA); PG8_STAGE(PG8_SB(1, 1), cB + hstepB + kstep, voffB);
        PG8_WAIT_V(6); PG8_BAR;
    } else {
        PG8_STAGE(PG8_SB(0, 0), cB, voffB); PG8_STAGE(PG8_SA(0, 0), cA, voffA); PG8_STAGE(PG8_SB(0, 1), cB + hstepB, voffB); PG8_STAGE(PG8_SA(0, 1), cA + hstep, voffA);
        if (wr == 1) PG8_BAR;
        PG8_WAIT_V(4); PG8_BAR;
        PG8_STAGE(PG8_SB(1, 0), cB + kstep, voffB); PG8_STAGE(PG8_SA(1, 0), cA + kstep, voffA); PG8_STAGE(PG8_SB(1, 1), cB + hstepB + kstep, voffB);
        PG8_WAIT_V(6); PG8_BAR;
    }
    for (;;) {
        const bool has_next = S.next(ui + 1, nxt);
        const char* nA = has_next ? (const char*)g.A + (size_t)nxt.pm * tstep : cA; const char* nB = has_next ? (const char*)g.Bt + (size_t)nxt.pn * tstep : cB;
        for (int t = 0; t < nt; t += 2) {
            const bool last = (t == nt - 2);
            const char* a1 = cA + (size_t)(t + 1) * kstep;
            const char* a2 = last ? nA : cA + (size_t)(t + 2) * kstep; const char* b2 = last ? nB : cB + (size_t)(t + 2) * kstep;
            const char* a3 = a2 + kstep; const char* b3 = b2 + kstep;
            if (last && has_next) S.a_ready(nxt);
            if constexpr (SP2) {
            PG8_LDB(B0, 0, 0); PG8_LDB(B1, 0, 1); PG8_SCHED; PG8_LDA(At, 0, 0); PG8_STAGE(PG8_SA(1, 1), a1 + hstep, voffA);
            PG8_WAIT_V(8); PG8_WAIT_L(0); PG8_BAR; PG8_MMA(0, 0, At, B0); PG8_MMA(0, 1, At, B1); PG8_BAR; PG8_SCHED;
            PG8_LDA(At, 0, 1); PG8_STAGE(PG8_SB(0, 0), b2, voffB); PG8_STAGE(PG8_SB(0, 1), b2 + hstepB, voffB); PG8_STAGE(PG8_SA(0, 0), a2, voffA);
            PG8_WAIT_V(8); PG8_WAIT_L(0); PG8_BAR; PG8_MMA(1, 0, At, B0); PG8_MMA(1, 1, At, B1); PG8_BAR; PG8_SCHED;
            PG8_LDB(B0, 1, 0); PG8_LDB(B1, 1, 1); PG8_SCHED; PG8_LDA(At, 1, 0); PG8_STAGE(PG8_SA(0, 1), a2 + hstep, voffA);
            PG8_WAIT_V(8); PG8_WAIT_L(0); PG8_BAR; PG8_MMA(0, 0, At, B0); PG8_MMA(0, 1, At, B1); PG8_BAR; PG8_SCHED;
            PG8_LDA(At, 1, 1); PG8_STAGE(PG8_SB(1, 0), b3, voffB); PG8_STAGE(PG8_SB(1, 1), b3 + hstepB, voffB); PG8_STAGE(PG8_SA(1, 0), a3, voffA);
            PG8_WAIT_V(8); PG8_WAIT_L(0); PG8_BAR; PG8_MMA(1, 0, At, B0); PG8_MMA(1, 1, At, B1); PG8_BAR; PG8_SCHED;
            } else {
            PG8_LDB(B0, 0, 0); PG8_SCHED; PG8_LDA(At, 0, 0); PG8_STAGE(PG8_SA(1, 1), a1 + hstep, voffA);
            PG8_WAIT_L(8); PG8_BAR; PG8_WAIT_L(0); PG8_MMA(0, 0, At, B0); PG8_BAR; PG8_SCHED;
            PG8_LDB(B1, 0, 1); PG8_STAGE(PG8_SB(0, 0), b2, voffB);
            PG8_BAR; PG8_WAIT_L(0); PG8_MMA(0, 1, At, B1); PG8_BAR;
            PG8_LDA(At, 0, 1); PG8_STAGE(PG8_SA(0, 0), a2, voffA);
            PG8_BAR; PG8_WAIT_L(0); PG8_MMA(1, 0, At, B0); PG8_BAR; PG8_SCHED;
            PG8_STAGE(PG8_SB(0, 1), b2 + hstepB, voffB);
            PG8_WAIT_V(6); PG8_BAR; PG8_MMA(1, 1, At, B1); PG8_BAR;
            PG8_LDB(B0, 1, 0); PG8_SCHED; PG8_LDA(At, 1, 0); PG8_STAGE(PG8_SA(0, 1), a2 + hstep, voffA);
            PG8_WAIT_L(8); PG8_BAR; PG8_WAIT_L(0); PG8_MMA(0, 0, At, B0); PG8_BAR; PG8_SCHED;
            PG8_LDB(B1, 1, 1); PG8_STAGE(PG8_SB(1, 0), b3, voffB);
            PG8_BAR; PG8_WAIT_L(0); PG8_MMA(0, 1, At, B1); PG8_BAR;
            PG8_LDA(At, 1, 1); PG8_STAGE(PG8_SA(1, 0), a3, voffA);
            PG8_BAR; PG8_WAIT_L(0); PG8_MMA(1, 0, At, B0); PG8_BAR; PG8_SCHED;
            PG8_STAGE(PG8_SB(1, 1), b3 + hstepB, voffB);
            PG8_WAIT_V(6); PG8_BAR; PG8_MMA(1, 1, At, B1); PG8_BAR;
            }
        }
        if constexpr (ALIGN_EPI) { if (wr == 0) PG8_BAR; }
        if constexpr (!Epi::AFTER_DRAIN) { E(acc, cur, wr, wc, fr, fq); S.done(cur); }
        if (!has_next) break;
#pragma unroll
        for (int a = 0; a < 2; ++a)
#pragma unroll
            for (int b = 0; b < 2; ++b)
#pragma unroll
                for (int m = 0; m < 4; ++m)
#pragma unroll
                    for (int n = 0; n < 2; ++n) acc[a][b][m][n] = (f32x4){0.f, 0.f, 0.f, 0.f};
        cur = nxt; cA = nA; cB = nB; ++ui;
        if constexpr (ALIGN_EPI) { if (wr == 1) PG8_BAR; }
    }
    PG8_WAIT_V(0);
    if constexpr (!ALIGN_EPI) { if (wr == 0) PG8_BAR; }
    PG8_BAR;
    if constexpr (Epi::AFTER_DRAIN) { E.fused(acc, cur, wr, wc, fr, fq, lds, wid, lane); S.done(cur); }
#undef PG8_SA
#undef PG8_SB
#undef PG8_STAGE
#undef PG8_LDA
#undef PG8_LDB
#undef PG8_MMA
#undef PG8_WAIT_V
#undef PG8_WAIT_L
#undef PG8_BAR
#undef PG8_SCHED
}
}
namespace attn_body {
using bf16=__hip_bfloat16;
using bf16x8=__attribute__((ext_vector_type(8)))short;
using s16x4=__attribute__((ext_vector_type(4)))short;
using f32x16=__attribute__((ext_vector_type(16)))float;
using u32x4=__attribute__((ext_vector_type(4)))unsigned;
constexpr int D=64;
constexpr int NW=8,QBLK=32,QB=QBLK*NW,KVBLK=64;
constexpr int ATTN_UNIT_ROWS=QB;
__device__ __forceinline__ int crow(int r,int hi){return (r&3)+8*(r>>2)+4*hi;}
#define SBAR() __builtin_amdgcn_sched_barrier(0)
__device__ __forceinline__ void cmask(f32x16&p0,f32x16&p1,int jb,int qrel,int hi){
  const float NEG=-INFINITY; int kb=64*jb+4*hi;
  #pragma unroll
  for(int r=0;r<16;++r){int kv=kb+(r&3)+8*(r>>2); if(kv>qrel)p0[r]=NEG; if(kv+32>qrel)p1[r]=NEG;}
}
template<int MODE> __device__ __forceinline__ void xmask(f32x16&p0,f32x16&p1,int t,int NT,int qrel,int hi,unsigned selm){
  const float NEG=-INFINITY; const int jb=t-(NT-4);
  if(MODE==4){ }
  else if(MODE==0||MODE==3||MODE==5){ if(jb>=0)cmask(p0,p1,jb,qrel,hi); }
  else if(MODE==1){ if(jb>=0)cmask(p0,p1,jb,qrel,hi); else if(!((selm>>(t>>2))&1u)){
      #pragma unroll
      for(int r=0;r<16;++r){p0[r]=NEG;p1[r]=NEG;} } }
  else{ const int kb=64*jb+4*hi;
    #pragma unroll
    for(int r=0;r<16;++r){int kv=kb+(r&3)+8*(r>>2); if(kv>qrel||kv<=qrel-128)p0[r]=NEG; if(kv+32>qrel||kv+32<=qrel-128)p1[r]=NEG;} }
}

constexpr int NSLOT=3, SLOTB=8192;
constexpr int LDS_K=0, LDS_V=NSLOT*SLOTB, LDS_WS=2*NSLOT*SLOTB, LDS_OST=LDS_WS+NW*64*4, LDS_BYTES=LDS_OST+NW*4096, LDS_V2=86016, V2OFF=LDS_V2-LDS_V;
constexpr float C2=0.125f*1.4426950408889634f;
__device__ __forceinline__ void glds16(const void*gsrc,unsigned lds_dst){unsigned keep;
  asm volatile("s_mov_b32 %0, m0\n\ts_mov_b32 m0, %2\n\ts_nop 0\n\tglobal_load_lds_dwordx4 %1, off\n\ts_mov_b32 m0, %0":"=&s"(keep):"v"(gsrc),"s"(lds_dst):"memory");}
__device__ __forceinline__ void glds16s(const void*sbase,unsigned voff,unsigned lds_dst){unsigned keep;
  asm volatile("s_mov_b32 %0, m0\n\ts_mov_b32 m0, %3\n\ts_nop 0\n\tglobal_load_lds_dwordx4 %1, %2\n\ts_mov_b32 m0, %0":"=&s"(keep):"v"(voff),"s"(sbase),"s"(lds_dst):"memory");}
__device__ __forceinline__ float max3f(float a,float b,float c){float r;asm("v_max3_f32 %0, %1, %2, %3":"=v"(r):"v"(a),"v"(b),"v"(c));return r;}
__device__ __forceinline__ float max2f(float a,float b){float r;asm("v_max_f32_e32 %0, %1, %2":"=v"(r):"v"(a),"v"(b));return r;}
__device__ __forceinline__ float fadd_s(float a,float b){float r;asm("v_add_f32_e32 %0, %1, %2":"=v"(r):"v"(a),"v"(b));return r;}
__device__ __forceinline__ float fsub_s(float a,float b){float r;asm("v_sub_f32_e32 %0, %1, %2":"=v"(r):"v"(a),"v"(b));return r;}
typedef float f32x2_t __attribute__((ext_vector_type(2))); typedef __bf16 bf16x2_t __attribute__((ext_vector_type(2)));
__device__ __forceinline__ unsigned cvtpk_s(float lo,float hi){f32x2_t v={lo,hi};bf16x2_t b=__builtin_convertvector(v,bf16x2_t);return __builtin_bit_cast(unsigned,b);}
#define WAIT_BAR(N) asm volatile("s_waitcnt vmcnt(" #N ") lgkmcnt(0)\n\ts_barrier":::"memory")

__device__ __forceinline__ void qkt(f32x16&p0,f32x16&p1,const char*Kslot,const bf16x8*qr,const f32x16&negm,int r32,int hi){
  const char*kb=Kslot+hi*1024+r32*16;
  #pragma unroll
  for(int d0=0;d0<4;++d0){
    const bf16x8 b0=*reinterpret_cast<const bf16x8*>(kb+d0*2048);
    const bf16x8 b1=*reinterpret_cast<const bf16x8*>(kb+d0*2048+512);
    if(d0==0){p0=__builtin_amdgcn_mfma_f32_32x32x16_bf16(b0,qr[0],negm,0,0,0);p1=__builtin_amdgcn_mfma_f32_32x32x16_bf16(b1,qr[0],negm,0,0,0);}
    else{p0=__builtin_amdgcn_mfma_f32_32x32x16_bf16(b0,qr[d0],p0,0,0,0);p1=__builtin_amdgcn_mfma_f32_32x32x16_bf16(b1,qr[d0],p1,0,0,0);}}
}
typedef __attribute__((address_space(3))) const char* lds_cptr;
typedef short v4i16_t __attribute__((ext_vector_type(4)));
__device__ __forceinline__ void kload8(bf16x8*kf,lds_cptr kp){
  kf[0]=*(const __attribute__((address_space(3))) bf16x8*)(kp);      kf[1]=*(const __attribute__((address_space(3))) bf16x8*)(kp+512);
  kf[2]=*(const __attribute__((address_space(3))) bf16x8*)(kp+2048); kf[3]=*(const __attribute__((address_space(3))) bf16x8*)(kp+2560);
  kf[4]=*(const __attribute__((address_space(3))) bf16x8*)(kp+4096); kf[5]=*(const __attribute__((address_space(3))) bf16x8*)(kp+4608);
  kf[6]=*(const __attribute__((address_space(3))) bf16x8*)(kp+6144); kf[7]=*(const __attribute__((address_space(3))) bf16x8*)(kp+6656);
}
__device__ __forceinline__ void kload2(bf16x8*kf,lds_cptr kp,int j){ kf[2*j]=*(const __attribute__((address_space(3))) bf16x8*)(kp+j*2048); kf[2*j+1]=*(const __attribute__((address_space(3))) bf16x8*)(kp+j*2048+512); }
__device__ __forceinline__ s16x4 vtr(lds_cptr p){ return __builtin_bit_cast(s16x4,__builtin_amdgcn_ds_read_tr16_b64_v4i16((__attribute__((address_space(3))) v4i16_t*)p)); }
__device__ __forceinline__ float rowmax(const f32x16&p0,const f32x16&p1){
  float a=max3f(p0[0],p0[1],p1[0]),b=max3f(p0[2],p0[3],p1[1]);a=max3f(a,p1[2],p1[3]);
  #pragma unroll
  for(int r=4;r<16;r+=4){a=max3f(a,p0[r],p0[r+1]);b=max3f(b,p0[r+2],p0[r+3]);a=max3f(a,p1[r],p1[r+1]);b=max3f(b,p1[r+2],p1[r+3]);}
  const float m=max2f(a,b);
  auto rr=__builtin_amdgcn_permlane32_swap(__float_as_uint(m),__float_as_uint(m),false,false);
  return max2f(__uint_as_float(rr[0]),__uint_as_float(rr[1]));
}
__device__ __forceinline__ void pv(f32x16*o,int vb,bf16x8 pa0,bf16x8 pa1,bf16x8 pa2,bf16x8 pa3){
  #pragma unroll
  for(int d0=0;d0<2;++d0){s16x4 lo[4],hi[4];
    #pragma unroll
    for(int ks=0;ks<4;++ks){
      asm volatile("ds_read_b64_tr_b16 %0,%1 offset:%c2":"=&v"(lo[ks]):"v"(vb),"i"(d0*4096+ks*1024):"memory");
      asm volatile("ds_read_b64_tr_b16 %0,%1 offset:%c2":"=&v"(hi[ks]):"v"(vb),"i"(d0*4096+ks*1024+512):"memory");}
    asm volatile("s_waitcnt lgkmcnt(0)":::"memory");SBAR();
    #define PK(k) (bf16x8){lo[k][0],lo[k][1],lo[k][2],lo[k][3],hi[k][0],hi[k][1],hi[k][2],hi[k][3]}
    o[d0]=__builtin_amdgcn_mfma_f32_32x32x16_bf16(pa0,PK(0),o[d0],0,0,0);
    o[d0]=__builtin_amdgcn_mfma_f32_32x32x16_bf16(pa1,PK(1),o[d0],0,0,0);
    o[d0]=__builtin_amdgcn_mfma_f32_32x32x16_bf16(pa2,PK(2),o[d0],0,0,0);
    o[d0]=__builtin_amdgcn_mfma_f32_32x32x16_bf16(pa3,PK(3),o[d0],0,0,0);
    #undef PK
  }
}

#ifndef ATTN_STORE16
#define ATTN_STORE16(p,v) (*(u32x4*)(p)=(v))
#endif
struct SpArgs { const unsigned short* el; int nvalid, nsel, h; long tok0; bf16* d0; bf16* d1; bf16* d2; float* lse; };
constexpr long LSE_STRIDE=32768L*16;
template<int MODE,int THRL> __device__ __forceinline__ void attn_unit(const bf16*Qu,const bf16*__restrict__ Ku,const bf16*__restrict__ Vu,bf16*Ou,const int NT,const unsigned*selp,const float sinkl2,char*shm,const SpArgs sp=SpArgs{},const unsigned entq_in=0u){
  constexpr int ld=(MODE==2||MODE==6)?1280:3072, ldo=(MODE==0||MODE==3)?2048:1024; constexpr bool DV2=(MODE==3);
  int tid_=threadIdx.x; asm volatile("":"+v"(tid_)); const int tid=tid_,lane=tid&63,r32=lane&31,hi=lane>>5; const int wid=__builtin_amdgcn_readfirstlane(tid>>6);
  const bf16*Qw=(MODE==6)?(Qu+(wid>>2)*64+(long)((wid&3)*QBLK)*ld):(Qu+(long)(wid*QBLK)*ld);
  const bf16*Kh=Ku,*Vh=Vu;
  const unsigned lds0=(unsigned)(uintptr_t)shm;
  float*wsf=(float*)(shm+LDS_WS)+wid*64;
  unsigned selm_=0u; if(MODE==1)selm_=selp[(wid*QBLK+r32)*16];
  #define SELM() selm_
  const unsigned koff=(unsigned)(lane*ld+wid*8)*2u;
  const unsigned voffv=(unsigned)((16*(wid&3)+(lane>>2))*ld+(wid>>2)*32+(lane&3)*8)*2u;
  const unsigned kdst=lds0+LDS_K+wid*1024, vdst=lds0+LDS_V+wid*1024;
  #define DMA_K(t,slot) glds16s(Kh+(long)(t)*KVBLK*ld,koff,(unsigned)__builtin_amdgcn_readfirstlane(kdst+(slot)))
  #define DMA_V(t,slot) do{ glds16s(Vh+(long)(t)*KVBLK*ld,voffv,(unsigned)__builtin_amdgcn_readfirstlane(vdst+(slot))); if(DV2)glds16s(Vh+64+(long)(t)*KVBLK*ld,voffv,(unsigned)__builtin_amdgcn_readfirstlane(vdst+V2OFF+(slot))); }while(0)
  #define WB(N2,N3) do{ if(DV2){WAIT_BAR(N3);}else{WAIT_BAR(N2);} }while(0)
  const int vb0=(int)(lds0+LDS_V)+((lane>>4)&1)*32+(lane&3)*8+(4*hi+((lane&15)>>2))*64;
  const char*Kbase=shm+LDS_K; bf16x8 kf[8];
  const lds_cptr shm3=(lds_cptr)shm; const lds_cptr kp0=shm3+LDS_K+hi*1024+r32*16; const lds_cptr vp0=shm3+LDS_V+((lane>>4)&1)*32+(lane&3)*8+(4*hi+((lane&15)>>2))*64;
  DMA_K(0,0);DMA_V(0,0);DMA_K(1,SLOTB);
  bf16x8 qr[4];
  const unsigned entq=(MODE==4)?entq_in:0u;
  const bf16*Qrow=(MODE==4)?(Qu+(long)(entq&0x1FFFu)*ld):(Qw+(long)r32*ld);
  #pragma unroll
  for(int d0=0;d0<4;++d0)qr[d0]=*reinterpret_cast<const bf16x8*>(&Qrow[d0*16+hi*8]);
  float mhat=0.f,l_reg=0.f;f32x16 o[DV2?4:2];o[0]=f32x16{};o[1]=f32x16{};if(DV2){o[DV2?2:0]=f32x16{};o[DV2?3:1]=f32x16{};}const f32x16 zero16=f32x16{};
  const int qrel=((MODE==6)?(wid&3):wid)*QBLK+r32;
  #define CMASK(P0,P1,t) xmask<(MODE==6)?2:MODE>(P0,P1,(t),(MODE==6)?(sp.nsel+4):NT,qrel,hi,(MODE==1)?SELM():0u)
  bool resc=false;
  #define START(P0,P1) do{ const float rm=rowmax(P0,P1); resc=false; \
    { const float dl=(MODE==0||MODE==3||MODE==4||MODE==5)?rm:__builtin_fmaxf(rm,-64.f); mhat=fadd_s(mhat,dl); \
      _Pragma("unroll") for(int r=0;r<16;++r){P0[r]=fsub_s(P0[r],dl);P1[r]=fsub_s(P1[r],dl);} \
      } \
    _Pragma("unroll") for(int r=0;r<16;++r)P0[r]=__builtin_amdgcn_exp2f(P0[r]); }while(0)
  #define RESC() do{ if(resc){ asm volatile("s_waitcnt lgkmcnt(0)":::"memory"); \
      _Pragma("unroll") for(int d_=0;d_<(DV2?4:2);++d_) _Pragma("unroll") for(int r=0;r<16;++r)o[d_][r]*=wsf[crow(r,hi)]; } }while(0)
  f32x16 pA0,pA1,pB0,pB1;
  int sl_prev=0,sl_cur=0,sl_next=SLOTB;
  #define ROT() do{sl_prev=sl_cur;sl_cur=sl_next;sl_next=(sl_next==(NSLOT-1)*SLOTB)?0:sl_next+SLOTB;}while(0)
  DMA_K(2,2*SLOTB);
  WB(3,4);
  qkt(pA0,pA1,Kbase,qr,zero16,r32,hi);asm volatile("s_nop 15\n\ts_nop 7":"+v"(pA0),"+v"(pA1));CMASK(pA0,pA1,0);
  START(pA0,pA1);
  _Pragma("unroll") for(int r=0;r<16;++r)pA1[r]=__builtin_amdgcn_exp2f(pA1[r]);
  WAIT_BAR(0);
  DMA_K(3,0);DMA_V(1,SLOTB);
  ROT();
  kload8(kf,kp0+sl_cur);
  WB(2,3);
  s16x4 vlo[8],vhi[8]; u32x4 pw0,pw1,pw2,pw3;
  #define PKW(P,B) cvtpk_s(P[B],P[B+1])
  #define PAF(k) __builtin_bit_cast(bf16x8,pw##k)
  #define VFR(i) (bf16x8){vlo[i][0],vlo[i][1],vlo[i][2],vlo[i][3],vhi[i][0],vhi[i][1],vhi[i][2],vhi[i][3]}
  #define PIN(x) asm volatile("":"+v"(x))
  #define MX3(a,b,c) __builtin_fmaxf(__builtin_fmaxf((a),(b)),(c))
  #define GAPA(MF,A0,A1,A2,A3,W0,W1,PW) do{ MF; sacc+=A0; sacc+=A1; sacc+=A2; sacc+=A3; PIN(sacc); W0; W1; PIN(PW); SBAR(); }while(0)
  #define EX(v) __builtin_amdgcn_exp2f(v)
  #define GAPB(MF,X,B) do{ MF; X[B]=EX(X[B]); X[B+1]=EX(X[B+1]); X[B+2]=EX(X[B+2]); X[B+3]=EX(X[B+3]); PIN(X); SBAR(); }while(0)
  #define VRD(i) do{ vlo[i]=vtr(vp_+(((i)>>2)*4096+((i)&3)*1024)); vhi[i]=vtr(vp_+(((i)>>2)*4096+((i)&3)*1024+512)); }while(0)
  #define KRD(G,j) do{ if(G){ kload2(kf,kp0+sl_next,j); SBAR(); } }while(0)
  #define STEP(C0,C1,P0,P1,t,GK,GV,GL) do{ SBAR(); \
    const lds_cptr vp_=vp0+sl_prev; \
    VRD(0); SBAR(); float sacc=(P0[0]+P0[1]); \
    GAPA(C0=__builtin_amdgcn_mfma_f32_32x32x16_bf16(kf[0],qr[0],zero16,0,0,0), P0[2],P0[3],P0[4],P0[5],     pw0[0]=PKW(P0,0), pw0[1]=PKW(P0,2), pw0); \
    VRD(4); SBAR(); GAPA(C1=__builtin_amdgcn_mfma_f32_32x32x16_bf16(kf[1],qr[0],zero16,0,0,0), P0[6],P0[7],P0[8],P0[9],     pw0[2]=PKW(P0,4), pw0[3]=PKW(P0,6), pw0); \
    VRD(1); SBAR(); GAPA(C0=__builtin_amdgcn_mfma_f32_32x32x16_bf16(kf[2],qr[1],C0,0,0,0),   P0[10],P0[11],P0[12],P0[13], pw1[0]=PKW(P0,8), pw1[1]=PKW(P0,10), pw1); \
    VRD(5); SBAR(); GAPA(C1=__builtin_amdgcn_mfma_f32_32x32x16_bf16(kf[3],qr[1],C1,0,0,0),   P0[14],P0[15],P1[0],P1[1],   pw1[2]=PKW(P0,12),pw1[3]=PKW(P0,14), pw1); \
    VRD(2); SBAR(); GAPA(C0=__builtin_amdgcn_mfma_f32_32x32x16_bf16(kf[4],qr[2],C0,0,0,0),   P1[2],P1[3],P1[4],P1[5],     pw2[0]=PKW(P1,0), pw2[1]=PKW(P1,2), pw2); \
    VRD(6); SBAR(); GAPA(C1=__builtin_amdgcn_mfma_f32_32x32x16_bf16(kf[5],qr[2],C1,0,0,0),   P1[6],P1[7],P1[8],P1[9],     pw2[2]=PKW(P1,4), pw2[3]=PKW(P1,6), pw2); \
    VRD(3); SBAR(); GAPA(C0=__builtin_amdgcn_mfma_f32_32x32x16_bf16(kf[6],qr[3],C0,0,0,0),   P1[10],P1[11],P1[12],P1[13], pw3[0]=PKW(P1,8), pw3[1]=PKW(P1,10), pw3); \
    VRD(7); SBAR(); GAPA(C1=__builtin_amdgcn_mfma_f32_32x32x16_bf16(kf[7],qr[3],C1,0,0,0),   P1[14],P1[15],0.f,0.f,       pw3[2]=PKW(P1,12),pw3[3]=PKW(P1,14), pw3); \
    l_reg+=sacc; \
    if(GK){DMA_K((t)+3,sl_cur);} if(GV){DMA_V((t)+1,sl_next);} \
    { float msub_=mhat; if(MODE==1){ if((t)<NT-4 && !((SELM()>>((t)>>2))&1u)) msub_=INFINITY; }     \
      _Pragma("unroll") for(int r=0;r<16;++r){C0[r]-=msub_;C1[r]-=msub_;} } \
    CMASK(C0,C1,t); \
    { float a=MX3(C0[0],C0[1],C1[0]),b=MX3(C0[2],C0[3],C1[1]); a=MX3(a,C1[2],C1[3]); \
      _Pragma("unroll") for(int r=4;r<16;r+=4){a=MX3(a,C0[r],C0[r+1]);b=MX3(b,C0[r+2],C0[r+3]);a=MX3(a,C1[r],C1[r+1]);b=MX3(b,C1[r+2],C1[r+3]);} \
      float rm=__builtin_fmaxf(a,b); { auto rr=__builtin_amdgcn_permlane32_swap(__float_as_uint(rm),__float_as_uint(rm),false,false); rm=__builtin_fmaxf(__uint_as_float(rr[0]),__uint_as_float(rr[1])); } \
      resc=false; \
      if(__builtin_expect(__any(rm>(float)THRL),0)){ const float dl=__builtin_fmaxf(rm,0.f); mhat+=dl; \
        _Pragma("unroll") for(int r=0;r<16;++r){C0[r]-=dl;C1[r]-=dl;} \
        const float f=__builtin_amdgcn_exp2f(-dl); l_reg*=f; if(hi==0)wsf[r32]=f; resc=true; } } \
    SBAR(); __builtin_amdgcn_s_setprio(1); \
    GAPB(o[0]=__builtin_amdgcn_mfma_f32_32x32x16_bf16(PAF(0),VFR(0),o[0],0,0,0), C0,0); \
    GAPB(o[1]=__builtin_amdgcn_mfma_f32_32x32x16_bf16(PAF(0),VFR(4),o[1],0,0,0), C0,4); \
    KRD(GL,0); GAPB(o[0]=__builtin_amdgcn_mfma_f32_32x32x16_bf16(PAF(1),VFR(1),o[0],0,0,0), C0,8); \
    KRD(GL,1); GAPB(o[1]=__builtin_amdgcn_mfma_f32_32x32x16_bf16(PAF(1),VFR(5),o[1],0,0,0), C0,12); \
    KRD(GL,2); GAPB(o[0]=__builtin_amdgcn_mfma_f32_32x32x16_bf16(PAF(2),VFR(2),o[0],0,0,0), C1,0); \
    KRD(GL,3); GAPB(o[1]=__builtin_amdgcn_mfma_f32_32x32x16_bf16(PAF(2),VFR(6),o[1],0,0,0), C1,4); \
    GAPB(o[0]=__builtin_amdgcn_mfma_f32_32x32x16_bf16(PAF(3),VFR(3),o[0],0,0,0), C1,8); \
    GAPB(o[1]=__builtin_amdgcn_mfma_f32_32x32x16_bf16(PAF(3),VFR(7),o[1],0,0,0), C1,12); \
    __builtin_amdgcn_s_setprio(0); \
    }while(0)
  #define PV2() do{ if(DV2){ SBAR(); pv(o+(DV2?2:0),vb0+V2OFF+sl_prev,PAF(0),PAF(1),PAF(2),PAF(3)); SBAR(); } }while(0)
  int t=1;
  #undef CMASK
  #define CMASK(P0,P1,t) do{}while(0)
  for(;t+5<NT;t+=2){
    STEP(pB0,pB1,pA0,pA1,t,true,true,true);     PV2(); WB(2,3); RESC(); ROT();
    STEP(pA0,pA1,pB0,pB1,t+1,true,true,true);   PV2(); WB(2,3); RESC(); ROT();
  }
  #undef CMASK
  #define CMASK(P0,P1,t) xmask<(MODE==6)?2:MODE>(P0,P1,(t),(MODE==6)?(sp.nsel+4):NT,qrel,hi,(MODE==1)?SELM():0u)
  #define ENDW(tt) do{ if((tt)+3<NT){WB(2,3);} else if((tt)+2<NT){WB(1,2);} else {WAIT_BAR(0);} }while(0)
  for(;t+1<NT;t+=2){
    STEP(pB0,pB1,pA0,pA1,t,(t+3<NT),(t+1<NT),(t+1<NT));       PV2(); ENDW(t);   RESC(); ROT();
    STEP(pA0,pA1,pB0,pB1,t+1,(t+4<NT),(t+2<NT),(t+2<NT));     PV2(); ENDW(t+1); RESC(); ROT();
  }
  STEP(pB0,pB1,pA0,pA1,NT-1,false,false,false); PV2(); RESC();
  { float sacc=pB0[0]+pB0[1]; _Pragma("unroll") for(int r=2;r<16;++r)sacc+=pB0[r]; _Pragma("unroll") for(int r=0;r<16;++r)sacc+=pB1[r]; l_reg+=sacc;
    pw0=(u32x4){PKW(pB0,0),PKW(pB0,2),PKW(pB0,4),PKW(pB0,6)};pw1=(u32x4){PKW(pB0,8),PKW(pB0,10),PKW(pB0,12),PKW(pB0,14)};pw2=(u32x4){PKW(pB1,0),PKW(pB1,2),PKW(pB1,4),PKW(pB1,6)};pw3=(u32x4){PKW(pB1,8),PKW(pB1,10),PKW(pB1,12),PKW(pB1,14)};
    SBAR(); pv(o,vb0+sl_cur,PAF(0),PAF(1),PAF(2),PAF(3)); if(DV2)pv(o+(DV2?2:0),vb0+V2OFF+sl_cur,PAF(0),PAF(1),PAF(2),PAF(3)); }
  #undef PV2
  #undef PKW
  #undef PAF
  #undef VFR
  #undef PIN
  #undef MX3
  #undef GAPA
  #undef GAPB
  #undef EX
  #undef VRD
  #undef KRD
  #undef STEP
  #undef ENDW
  {auto rr=__builtin_amdgcn_permlane32_swap(__float_as_uint(l_reg),__float_as_uint(l_reg),false,false);l_reg=__uint_as_float(rr[0])+__uint_as_float(rr[1]);}
  if(MODE==2)l_reg+=__builtin_amdgcn_exp2f(sinkl2-mhat);
  if(MODE==6)l_reg+=__builtin_amdgcn_exp2f(((const float*)selp)[wid>>2]*(C2*8.0f)-mhat);
  if(MODE==4){ if(hi==0&&wid*QBLK+r32<sp.nvalid)sp.lse[(long)(entq>>13)*LSE_STRIDE+(sp.tok0+(long)(entq&0x1FFFu))*16+sp.h]=mhat+__builtin_amdgcn_logf(l_reg); }
  const float lse_own=mhat+__builtin_amdgcn_logf(l_reg);
  if(hi==0)wsf[32+r32]=l_reg;asm volatile("s_waitcnt lgkmcnt(0)":::"memory");
  float rli[16];
  #pragma unroll
  for(int r=0;r<16;++r)rli[r]=__builtin_amdgcn_rcpf(wsf[32+crow(r,hi)]);
  bf16*Ow=(MODE==6)?(Ou+(wid>>2)*64+(long)((wid&3)*QBLK)*ldo):(Ou+(long)(wid*QBLK)*ldo);
  { bf16*stg=(bf16*)(shm+LDS_OST)+wid*2048;
    #pragma unroll
    for(int r=0;r<16;++r){const int orow=crow(r,hi);
      #pragma unroll
      for(int d0=0;d0<2;++d0)stg[orow*64+d0*32+r32]=__float2bfloat16(o[d0][r]*rli[r]);}
    asm volatile("s_waitcnt lgkmcnt(0)":::"memory");
    if(MODE==4){
      unsigned e4_[4];
      #pragma unroll
      for(int i=0;i<4;++i){const int ri_=wid*QBLK+i*8+(lane>>3); const unsigned ev_=(unsigned)__builtin_amdgcn_ds_bpermute((i*8+(lane>>3))<<2,(int)entq); e4_[i]=(ri_<sp.nvalid)?ev_:0xFFFFFFFFu;}
      #pragma unroll
      for(int i=0;i<4;++i){const int row=i*8+(lane>>3),ch=lane&7;
        if(e4_[i]!=0xFFFFFFFFu){ const unsigned e_=e4_[i]; const long tk_=sp.tok0+(long)(e_&0x1FFFu); const unsigned sl_=e_>>13;
          bf16*dst_=(sl_==0u)?(sp.d0+tk_*1024+sp.h*64):(((sl_==1u)?sp.d1:sp.d2)+(tk_*16+sp.h)*64);
          const u32x4 v=*(const u32x4*)(stg+row*64+ch*8); ATTN_STORE16(dst_+ch*8,v); } }
    } else if(MODE==5){
      if(hi==0)wsf[32+r32]=lse_own; asm volatile("s_waitcnt lgkmcnt(0)":::"memory");
      float ls4_[4][3]; u32x4 pv4_[4][3];
      #pragma unroll
      for(int i=0;i<4;++i){const int row=i*8+(lane>>3),ch=lane&7; const long tk_=sp.tok0+wid*QBLK+row;
        #pragma unroll
        for(int s_=0;s_<3;++s_){ ls4_[i][s_]=-INFINITY; pv4_[i][s_]=(u32x4){0u,0u,0u,0u};
          if(s_<sp.nsel){ ls4_[i][s_]=sp.lse[(long)s_*LSE_STRIDE+tk_*16+sp.h];
            const bf16*src_=(s_==0)?(sp.d0+tk_*1024+sp.h*64):(((s_==1)?sp.d1:sp.d2)+(tk_*16+sp.h)*64); pv4_[i][s_]=*(const u32x4*)(src_+ch*8); } } }
      #pragma unroll
      for(int i=0;i<4;++i){const int row=i*8+(lane>>3),ch=lane&7; const long tk_=sp.tok0+wid*QBLK+row; const float lo_=wsf[32+row];
        const u32x4 v=*(const u32x4*)(stg+row*64+ch*8);
        float m_=lo_;
        #pragma unroll
        for(int s_=0;s_<3;++s_)m_=__builtin_fmaxf(m_,ls4_[i][s_]);
        float w_=__builtin_amdgcn_exp2f(lo_-m_),den_=w_; float a_[8];
        #pragma unroll
        for(int e=0;e<4;++e){ a_[2*e]=w_*__uint_as_float(v[e]<<16); a_[2*e+1]=w_*__uint_as_float(v[e]&0xffff0000u); }
        #pragma unroll
        for(int s_=0;s_<3;++s_){ const float ws_=__builtin_amdgcn_exp2f(ls4_[i][s_]-m_); den_+=ws_;
            #pragma unroll
            for(int e=0;e<4;++e){ a_[2*e]+=ws_*__uint_as_float(pv4_[i][s_][e]<<16); a_[2*e+1]+=ws_*__uint_as_float(pv4_[i][s_][e]&0xffff0000u); } }
        const float inv_=__builtin_amdgcn_rcpf(den_);
        u32x4 o_; o_[0]=cvtpk_s(a_[0]*inv_,a_[1]*inv_); o_[1]=cvtpk_s(a_[2]*inv_,a_[3]*inv_); o_[2]=cvtpk_s(a_[4]*inv_,a_[5]*inv_); o_[3]=cvtpk_s(a_[6]*inv_,a_[7]*inv_);
        ATTN_STORE16(sp.d0+tk_*1024+sp.h*64+ch*8,o_); }
    } else {
    #pragma unroll
    for(int i=0;i<4;++i){const int row=i*8+(lane>>3),ch=lane&7; const u32x4 v=*(const u32x4*)(stg+row*64+ch*8); ATTN_STORE16(Ow+(long)row*ldo+ch*8,v);}
    }
    if(DV2){ asm volatile("s_waitcnt lgkmcnt(0)":::"memory");
      #pragma unroll
      for(int r=0;r<16;++r){const int orow=crow(r,hi);
        #pragma unroll
        for(int d0=0;d0<2;++d0)stg[orow*64+d0*32+r32]=__float2bfloat16(o[DV2?2+d0:d0][r]*rli[r]);}
      asm volatile("s_waitcnt lgkmcnt(0)":::"memory");
      #pragma unroll
      for(int i=0;i<4;++i){const int row=i*8+(lane>>3),ch=lane&7; const u32x4 v=*(const u32x4*)(stg+row*64+ch*8); ATTN_STORE16(Ow+(long)row*ldo+64+ch*8,v);} } }
  asm volatile("s_waitcnt lgkmcnt(0)\n\ts_barrier":::"memory");
  #undef SELM
  #undef DMA_K
  #undef DMA_V
  #undef WB
  #undef CMASK
  #undef START
  #undef RESC
  #undef ROT
}
constexpr int ATTN_LDS_BYTES=LDS_BYTES;
#undef SBAR
#undef WAIT_BAR
}
#define GAS __attribute__((address_space(1)))
#define LAS __attribute__((address_space(3)))
typedef unsigned short bf16;
typedef unsigned v4u __attribute__((ext_vector_type(4)));
typedef unsigned v2u __attribute__((ext_vector_type(2)));
typedef float f32x4 __attribute__((ext_vector_type(4)));
typedef short bf16x8 __attribute__((ext_vector_type(8)));
#define LDS_WAIT() asm volatile("s_waitcnt lgkmcnt(0)" ::: "memory")

constexpr int NB = 4, SEQ = 8192, T = NB * SEQ, DM = 1024, DFF = 4096, DEPTH = 4, NH = 16;
constexpr float EPS = 1e-6f;
constexpr float LOG2E = 1.4426950408889634f;
constexpr size_t MiB = 1u << 20;
constexpr size_t WS_W = 0, W_LAYER = 24 * MiB, W_IN = 0, W_OUT = 6 * MiB, W_UP = 8 * MiB, W_DOWN = 16 * MiB;
constexpr size_t WS_ROPE = 96 * MiB, WS_SEL = 98 * MiB, WS_KM = 100 * MiB, WS_XN = 102 * MiB, WS_QKV = 166 * MiB, WS_O2 = 358 * MiB, WS_U = 166 * MiB, WS_HB = 422 * MiB, WS_RSQ = 486 * MiB, WS_CTL = 488 * MiB, WS_LSE = 489 * MiB, WS_END = 495 * MiB;
constexpr size_t WS_CNT = WS_CTL + 65536;
constexpr size_t WS_LIST = WS_W;
constexpr size_t WS_P1 = WS_O2, WS_P2 = WS_O2 + 64 * MiB;
constexpr int LDS_PRE = 98304, LDS_TMP = 110592;
constexpr int LDS_BYTES = 147456, LDSCTL_OFF = 131072;
constexpr int NWAVES = 8;

__device__ __forceinline__ float bf2f(unsigned short b) { return __uint_as_float((unsigned)b << 16); }
__device__ __forceinline__ float shx(float v, int k, int lane) { return __int_as_float(__builtin_amdgcn_ds_bpermute((lane ^ k) << 2, __float_as_int(v))); }
__device__ __forceinline__ float wave_sum(float v, int lane) {
#pragma unroll
    for (int o = 1; o < 64; o <<= 1) v += shx(v, o, lane);
    return v;
}
__device__ __forceinline__ void transpose_item(const float* W, const float* gk, int K, int N, bf16* WT, LAS float* scr, int item, int lane) {
    const int nblk = N / 32, kb = item / nblk, nb = item % nblk, k0 = 64 * kb, n0 = 32 * nb;
#pragma unroll 8
    for (int i = 0; i < 32; ++i) { const int kk = 2 * i + (lane >> 5); scr[kk * 33 + (lane & 31)] = W[(size_t)(k0 + kk) * N + n0 + (lane & 31)] * (gk ? gk[k0 + kk] : 1.f); }
    LDS_WAIT(); asm volatile("" ::: "memory");
    const int c = lane & 7;
#pragma unroll
    for (int j = 0; j < 4; ++j) { const int n = (lane >> 3) + 8 * j; const LAS float* s = scr + (8 * c) * 33 + n;
        v4u o; o.x = pg8::cvt_pk_bf16(s[0 * 33], s[1 * 33]); o.y = pg8::cvt_pk_bf16(s[2 * 33], s[3 * 33]); o.z = pg8::cvt_pk_bf16(s[4 * 33], s[5 * 33]); o.w = pg8::cvt_pk_bf16(s[6 * 33], s[7 * 33]);
        *(v4u*)(WT + (size_t)(n0 + n) * K + k0 + 8 * c) = o; }
    LDS_WAIT(); asm volatile("" ::: "memory");
}
__device__ __forceinline__ void rms_row_to_bf16(const float* xrow, const float* g, bf16* orow, int lane) {
    const f32x4* xr = (const f32x4*)xrow + lane; const f32x4* gr = (const f32x4*)g + lane;
    f32x4 v[4]; float s = 0.f;
#pragma unroll
    for (int j = 0; j < 4; ++j) { v[j] = xr[64 * j]; s += (v[j].x * v[j].x + v[j].y * v[j].y) + (v[j].z * v[j].z + v[j].w * v[j].w); }
    const float r = 1.0f / sqrtf(wave_sum(s, lane) * (1.f / DM) + EPS);
    v2u* o8 = (v2u*)orow + lane;
#pragma unroll
    for (int j = 0; j < 4; ++j) { const f32x4 gg = gr[64 * j]; v2u w; w.x = pg8::cvt_pk_bf16(v[j].x * r * gg.x, v[j].y * r * gg.y); w.y = pg8::cvt_pk_bf16(v[j].z * r * gg.z, v[j].w * r * gg.w); o8[64 * j] = w; }
}
__device__ __forceinline__ void row_to_bf16_sumsq(const float* xrow, bf16* orow, float* rsq, int lane) {
    const f32x4* xr = (const f32x4*)xrow + lane;
    f32x4 v[4]; float s = 0.f;
#pragma unroll
    for (int j = 0; j < 4; ++j) { v[j] = xr[64 * j]; s += (v[j].x * v[j].x + v[j].y * v[j].y) + (v[j].z * v[j].z + v[j].w * v[j].w); }
    s = wave_sum(s, lane);
    v2u* o8 = (v2u*)orow + lane;
#pragma unroll
    for (int j = 0; j < 4; ++j) { v2u w; w.x = pg8::cvt_pk_bf16(v[j].x, v[j].y); w.y = pg8::cvt_pk_bf16(v[j].z, v[j].w); o8[64 * j] = w; }
    if (lane < 16) rsq[lane] = (lane == 0) ? s : 0.f;
}
__device__ __forceinline__ void rms_rowb_to_f32(const bf16* xrow, const float* g, float* orow, int lane) {
    const v2u* xr = (const v2u*)xrow + lane; const f32x4* gr = (const f32x4*)g + lane;
    f32x4 v[4]; float s = 0.f;
#pragma unroll
    for (int j = 0; j < 4; ++j) { const v2u q = xr[64 * j]; v[j] = (f32x4){__uint_as_float(q.x << 16), __uint_as_float(q.x & 0xffff0000u), __uint_as_float(q.y << 16), __uint_as_float(q.y & 0xffff0000u)};
        s += (v[j].x * v[j].x + v[j].y * v[j].y) + (v[j].z * v[j].z + v[j].w * v[j].w); }
    const float r = 1.0f / sqrtf(wave_sum(s, lane) * (1.f / DM) + EPS);
    f32x4* o = (f32x4*)orow + lane;
#pragma unroll
    for (int j = 0; j < 4; ++j) { const f32x4 gg = gr[64 * j]; o[64 * j] = (v[j] * r) * gg; }
}
__device__ __forceinline__ void rms_rowb2_to_f32(const bf16* xa, const bf16* xb, const float* g, float* oa, float* ob, int lane) {
    const v2u* xr[2] = {(const v2u*)xa + lane, (const v2u*)xb + lane}; const f32x4* gr = (const f32x4*)g + lane;
    v2u q[2][4];
#pragma unroll
    for (int r = 0; r < 2; ++r)
#pragma unroll
        for (int j = 0; j < 4; ++j) q[r][j] = xr[r][64 * j];
    f32x4 gg[4];
#pragma unroll
    for (int j = 0; j < 4; ++j) gg[j] = gr[64 * j];
#pragma unroll
    for (int r = 0; r < 2; ++r) { f32x4 v[4]; float s = 0.f;
#pragma unroll
        for (int j = 0; j < 4; ++j) { v[j] = (f32x4){__uint_as_float(q[r][j].x << 16), __uint_as_float(q[r][j].x & 0xffff0000u), __uint_as_float(q[r][j].y << 16), __uint_as_float(q[r][j].y & 0xffff0000u)};
            s += (v[j].x * v[j].x + v[j].y * v[j].y) + (v[j].z * v[j].z + v[j].w * v[j].w); }
        const float rr = 1.0f / sqrtf(wave_sum(s, lane) * (1.f / DM) + EPS);
        f32x4* o = (f32x4*)(r ? ob : oa) + lane;
#pragma unroll
        for (int j = 0; j < 4; ++j) o[64 * j] = (v[j] * rr) * gg[j]; }
}
__device__ __forceinline__ void rms_row_to_f32(const float* xrow, const float* g, float* orow, int lane) {
    const f32x4* xr = (const f32x4*)xrow + lane; const f32x4* gr = (const f32x4*)g + lane;
    f32x4 v[4]; float s = 0.f;
#pragma unroll
    for (int j = 0; j < 4; ++j) { v[j] = xr[64 * j]; s += (v[j].x * v[j].x + v[j].y * v[j].y) + (v[j].z * v[j].z + v[j].w * v[j].w); }
    const float r = 1.0f / sqrtf(wave_sum(s, lane) * (1.f / DM) + EPS);
    f32x4* o = (f32x4*)orow + lane;
#pragma unroll
    for (int j = 0; j < 4; ++j) { const f32x4 gg = gr[64 * j]; o[64 * j] = (v[j] * r) * gg; }
}

#define XB_TMO      128
#define XB_XCNT(j)  (256  + 64 * (j))
#define XB_XSUB(j)  (1280 + 64 * (j))
#define XB_XGEN(j)  (2304 + 64 * (j))
#define XB_TOP      3328
#define XB_TOPGEN   3392
#define XCD_BAR_WORDS 3456
#define XB_SPIN_CAP (1u << 18)

__device__ __forceinline__ unsigned xb_ld(unsigned* p)              { return __hip_atomic_load(p, __ATOMIC_RELAXED, __HIP_MEMORY_SCOPE_AGENT); }
__device__ __forceinline__ unsigned xb_add(unsigned* p, unsigned v) { return __hip_atomic_fetch_add(p, v, __ATOMIC_RELAXED, __HIP_MEMORY_SCOPE_AGENT); }
__device__ __forceinline__ unsigned xb_xcc_id() { return (unsigned)__builtin_amdgcn_s_getreg((3 << 11) | 20) & 0xFu; }
#define XB_SPIN(cond, bar) do { unsigned _sp = 0; while (cond) { __builtin_amdgcn_s_sleep(1); \
    if ((++_sp & 255u) == 0u) { if (xb_ld(&(bar)[XB_TMO])) break; if (_sp > XB_SPIN_CAP) { atomicAdd(&(bar)[XB_TMO], 1u); break; } } } } while (0)

struct XcdBarrier {
    unsigned* bar; unsigned x;
    volatile LAS unsigned* st;
};

__device__ __forceinline__ XcdBarrier xcd_barrier_post(unsigned* bar, volatile LAS unsigned* st) {
    XcdBarrier b; b.bar = bar; b.x = xb_xcc_id(); b.st = st;
    if (threadIdx.x == 0) (void)xb_add(&bar[XB_XCNT(b.x)], 1u);
    return b;
}
__device__ __forceinline__ void xcd_barrier_complete(unsigned* bar, unsigned x, unsigned& nloc, unsigned& nx) {
    const unsigned G = gridDim.x * gridDim.y * gridDim.z;
    unsigned sum, cnt, mine, sp = 0u;
    for (;;) {
        sum = 0u; cnt = 0u; mine = 0u;
#pragma unroll
        for (unsigned j = 0; j < 16; ++j) { const unsigned c = xb_ld(&bar[XB_XCNT(j)]); sum += c; cnt += (c > 0u) ? 1u : 0u; mine = (j == x) ? c : mine; }
        if (sum == G) break;
        __builtin_amdgcn_s_sleep(1);
        if ((++sp & 255u) == 0u) { if (xb_ld(&bar[XB_TMO])) break; if (sp > XB_SPIN_CAP) { atomicAdd(&bar[XB_TMO], 1u); break; } }
    }
    nloc = mine > 0u ? mine : 1u; nx = cnt > 0u ? cnt : 1u;
}

__device__ __forceinline__ void xcd_barrier(const XcdBarrier& b) {
    asm volatile("s_waitcnt vmcnt(0)" ::: "memory");
    __syncthreads();
    if (threadIdx.x == 0) {
        unsigned* bar = b.bar;
        __builtin_amdgcn_s_waitcnt(0);
        unsigned nloc = b.st[0], nx = b.st[1];
        if (nloc == 0u) { xcd_barrier_complete(bar, b.x, nloc, nx); b.st[0] = nloc; b.st[1] = nx; }
        const unsigned old = xb_add(&bar[XB_XSUB(b.x)], 1u);
        const unsigned gen = old / nloc;
        if (old + 1u == (gen + 1u) * nloc) {
            __builtin_amdgcn_fence(__ATOMIC_RELEASE, "agent");
            asm volatile("s_waitcnt vmcnt(0)" ::: "memory");
            const unsigned og = xb_add(&bar[XB_TOP], 1u);
            const unsigned tg = og / nx;
            if (og + 1u == (tg + 1u) * nx) xb_add(&bar[XB_TOPGEN], 1u);
            else XB_SPIN(xb_ld(&bar[XB_TOPGEN]) == tg, bar);
            __builtin_amdgcn_fence(__ATOMIC_ACQUIRE, "agent");
            xb_add(&bar[XB_XGEN(b.x)], 1u);
            asm volatile("s_waitcnt vmcnt(0)" ::: "memory");
        } else {
            XB_SPIN(xb_ld(&bar[XB_XGEN(b.x)]) == gen, bar);
            __builtin_amdgcn_fence(__ATOMIC_ACQUIRE, "agent");
            asm volatile("s_waitcnt vmcnt(0)" ::: "memory");
        }
    }
    __syncthreads();
}

struct Args { const float* in[20]; float* out; unsigned char* ws; };
typedef const Args __attribute__((address_space(4)))* KArgs;
__device__ __forceinline__ KArgs fresh_args() { KArgs p = (KArgs)__builtin_amdgcn_kernarg_segment_ptr(); asm volatile("" : "+s"(p)); return p; }

template <int L> __device__ __forceinline__ void layer_fwd(unsigned char* lds, const XcdBarrier& bar) {
#define ARGS_IN(k) (fresh_args()->in[k])
    int wave; { int t_ = threadIdx.x; asm volatile("" : "+v"(t_)); wave = __builtin_amdgcn_readfirstlane(t_ >> 6); }
#define FRESH_LANE() int lane; { int t_ = threadIdx.x; asm volatile("" : "+v"(t_)); lane = t_ & 63; }
    const int G = gridDim.x, bx = blockIdx.x;
    const int vcu = (G % 8 == 0) ? (bx % 8) * (G / 8) + bx / 8 : bx;
    const int gw = vcu * NWAVES + wave, NGW = G * NWAVES;
#define ws (fresh_args()->ws)
#define XIN (fresh_args()->in[0])
#define hbuf (fresh_args()->out)
#define ROPE ((float*)(ws + WS_ROPE))
#define SEL ((unsigned*)(ws + WS_SEL))
#define KM ((float*)(ws + WS_KM))
#define XN ((bf16*)(ws + WS_XN))
#define QKV ((bf16*)(ws + WS_QKV))
#define O2 ((bf16*)hbuf)
#define U ((bf16*)(ws + WS_U))
#define HB ((bf16*)(ws + WS_HB))
#define RSQ ((float*)(ws + WS_RSQ))
#define Win ((const bf16*)(ws + WS_W + (size_t)L * W_LAYER + W_IN))
#define Wout ((const bf16*)(ws + WS_W + (size_t)L * W_LAYER + W_OUT))
#define Wup ((const bf16*)(ws + WS_W + (size_t)L * W_LAYER + W_UP))
#define Wdown ((const bf16*)(ws + WS_W + (size_t)L * W_LAYER + W_DOWN))
    LAS unsigned char* ldsl = (LAS unsigned char*)lds;
    {
        constexpr int mixer = L % 3;
        constexpr int NQ = (mixer == 2) ? 1280 : 3072;
        {
            pg8::Gemm g{HB, Win, T, NQ, DM}; pg8::StaticOrder S; S.init(T, NQ, G, bx);
            pg8::EpiQKV E{QKV, NQ, (mixer == 2) ? ARGS_IN(14) : nullptr, ROPE, (mixer == 2) ? 1152 : 2048, 1024, attn_body::C2, RSQ};
            pg8::gemm_phase<pg8::EpiQKV, pg8::StaticOrder, true, true>(ldsl, g, S, E);
        }
        xcd_barrier(bar);
        if constexpr (mixer == 0) {
            for (int i = 0; i < 8; ++i) {
                int bh, qb;
                if (G == 256) { const int s = vcu & 7, k = i & 3; bh = (i >> 2) * 32 + (vcu >> 3); qb = (k == 0) ? s : (k == 1) ? 15 - s : (k == 2) ? 16 + s : 31 - s; }
                else break;
                const int b = bh >> 4, j = bh & 15;
                const size_t r0 = (size_t)b * SEQ, q0 = (size_t)qb * 256;
#ifndef NO_A0
                attn_body::attn_unit<3, 8>((const attn_body::bf16*)(QKV + (r0 + q0) * 3072 + j * 64), (const attn_body::bf16*)(QKV + r0 * 3072 + 1024 + j * 64),
                    (const attn_body::bf16*)(QKV + r0 * 3072 + 2048 + (j >> 1) * 128), (attn_body::bf16*)(O2 + (r0 + q0) * 2048 + j * 128), 4 * qb + 4, nullptr, 0.f, (char*)lds);
#endif
            }
            xcd_barrier(bar);
#ifndef NO_CMB
            {
                const int slot = L / 3;
                FRESH_LANE();
                const float lambda_init = 0.8f - 0.6f * expf(-0.3f * (float)L);
                const float s1 = wave_sum(ARGS_IN(6)[slot * 64 + lane] * ARGS_IN(7)[slot * 64 + lane], lane);
                const float s2 = wave_sum(ARGS_IN(8)[slot * 64 + lane] * ARGS_IN(9)[slot * 64 + lane], lane);
                const float lam = expf(s1) - expf(s2) + lambda_init;
                const int hh = lane >> 3, c = lane & 7;
                const float* sg = ARGS_IN(10) + slot * 128 + c * 16;
                float gsc[16];
#pragma unroll
                for (int e = 0; e < 16; ++e) gsc[e] = sg[e] * (1.f - lambda_init);
                for (int m = gw; m < T; m += NGW) {
                    const bf16* o0 = O2 + (size_t)m * 2048 + (2 * hh) * 128 + c * 16; const bf16* o1 = o0 + 128;
                    const bf16x8 a0 = *(const bf16x8*)o0, a1 = *(const bf16x8*)(o0 + 8), b0 = *(const bf16x8*)o1, b1 = *(const bf16x8*)(o1 + 8);
                    float v[16]; float ss = 0.f;
#pragma unroll
                    for (int e = 0; e < 8; ++e) { v[e] = bf2f((unsigned short)a0[e]) - lam * bf2f((unsigned short)b0[e]); v[8 + e] = bf2f((unsigned short)a1[e]) - lam * bf2f((unsigned short)b1[e]); }
#pragma unroll
                    for (int e = 0; e < 16; ++e) ss += v[e] * v[e];
                    ss += shx(ss, 1, lane); ss += shx(ss, 2, lane); ss += shx(ss, 4, lane);
                    const float r = 1.0f / sqrtf(ss * (1.f / 128.f) + EPS);
                    v4u w0, w1;
                    w0.x = pg8::cvt_pk_bf16(v[0] * r * gsc[0], v[1] * r * gsc[1]); w0.y = pg8::cvt_pk_bf16(v[2] * r * gsc[2], v[3] * r * gsc[3]);
                    w0.z = pg8::cvt_pk_bf16(v[4] * r * gsc[4], v[5] * r * gsc[5]); w0.w = pg8::cvt_pk_bf16(v[6] * r * gsc[6], v[7] * r * gsc[7]);
                    w1.x = pg8::cvt_pk_bf16(v[8] * r * gsc[8], v[9] * r * gsc[9]); w1.y = pg8::cvt_pk_bf16(v[10] * r * gsc[10], v[11] * r * gsc[11]);
                    w1.z = pg8::cvt_pk_bf16(v[12] * r * gsc[12], v[13] * r * gsc[13]); w1.w = pg8::cvt_pk_bf16(v[14] * r * gsc[14], v[15] * r * gsc[15]);
                    bf16* op = XN + (size_t)m * DM + hh * 128 + c * 16;
                    *(v4u*)op = w0; *(v4u*)(op + 8) = w1;
                }
            }
#endif
            xcd_barrier(bar);
        } else if constexpr (mixer == 1) {
            { FRESH_LANE();
            if (bx == 0) { unsigned* cz = (unsigned*)(ws + WS_CNT); for (int u_ = (int)threadIdx.x; u_ < 2048; u_ += NWAVES * 64) cz[u_] = 0u; }
            for (int it = gw; it < NB * NH * 32; it += NGW) {
                const int n = it & 31, h = (it >> 5) & 15, b = it >> 9; const int c = lane & 7, kg = lane >> 3;
                const bf16* kp = QKV + ((size_t)b * SEQ + n * 256 + kg) * 3072 + 1024 + h * 64 + c * 8;
                float a[8];
#pragma unroll
                for (int e = 0; e < 8; ++e) a[e] = 0.f;
#pragma unroll 8
                for (int i = 0; i < 32; ++i) { const bf16x8 kv = *(const bf16x8*)(kp + (size_t)i * 8 * 3072);
#pragma unroll
                    for (int e = 0; e < 8; ++e) a[e] += bf2f((unsigned short)kv[e]); }
#pragma unroll
                for (int e = 0; e < 8; ++e) { a[e] += shx(a[e], 8, lane); a[e] += shx(a[e], 16, lane); a[e] += shx(a[e], 32, lane); }
                if (kg == 0) { float* o = KM + (size_t)it * 64 + c * 8; *(f32x4*)o = (f32x4){a[0], a[1], a[2], a[3]} * (1.f / 256.f); *(f32x4*)(o + 4) = (f32x4){a[4], a[5], a[6], a[7]} * (1.f / 256.f); }
            } }
            xcd_barrier(bar);
            { FRESH_LANE();
            for (int it = gw; it < NB * NH * 128; it += NGW) {
                const int grp = it & 127, h = (it >> 7) & 15, b = it >> 11; const int own = grp >> 2;
                const int spos = grp * 64 + lane;
                const size_t tok = (size_t)b * SEQ + spos;
                const bf16* qp = QKV + tok * 3072 + h * 64;
                float q[64];
#pragma unroll
                for (int c = 0; c < 8; ++c) { const bf16x8 qv = *(const bf16x8*)(qp + c * 8);
#pragma unroll
                    for (int e = 0; e < 8; ++e) q[c * 8 + e] = bf2f((unsigned short)qv[e]); }
                float v0 = -INFINITY, v1 = -INFINITY, v2 = -INFINITY; int i0 = -1, i1 = -1, i2 = -1;
                const float* km = KM + (size_t)((b * NH + h) * 32) * 64;
                for (int n = 0; n < own; ++n) {
                    float d = 0.f;
#pragma unroll
                    for (int e = 0; e < 64; ++e) d += q[e] * km[n * 64 + e];
                    if (d > v0) { v2 = v1; i2 = i1; v1 = v0; i1 = i0; v0 = d; i0 = n; }
                    else if (d > v1) { v2 = v1; i2 = i1; v1 = d; i1 = n; }
                    else if (d > v2) { v2 = d; i2 = n; }
                }
                unsigned* cnt = (unsigned*)(ws + WS_CNT) + (b * NH + h) * 32;
                unsigned short* lst = (unsigned short*)(ws + WS_LIST) + (size_t)(b * NH + h) * 131072;
                unsigned mycnt = 0u;
                for (int n = 0; n < own; ++n) { const bool sel = (i0 == n) | (i1 == n) | (i2 == n); const unsigned long long mk = __ballot(sel); if (lane == n) mycnt = (unsigned)__popcll(mk); }
                unsigned mybase = 0u; if (mycnt) mybase = atomicAdd(cnt + lane, mycnt);
                for (int n = 0; n < own; ++n) {
                    const bool sel = (i0 == n) | (i1 == n) | (i2 == n);
                    const unsigned long long mk = __ballot(sel);
                    if (mk) {
                        const unsigned base = (unsigned)__builtin_amdgcn_readlane((int)mybase, n);
                        if (sel) { const int r = (i0 == n) ? 0 : (i1 == n) ? 1 : 2; const int rank = __popcll(mk & ((1ull << lane) - 1ull));
                            lst[256 * (31 * n - (n * (n - 1)) / 2) + base + rank] = (unsigned short)(spos | (r << 13)); }
                    }
                }
            } }
            xcd_barrier(bar);
            {
                LAS int* pre = (LAS int*)(ldsl + LDS_PRE); LAS int* tmp = (LAS int*)(ldsl + LDS_TMP); LAS int* cl = (LAS int*)(ldsl + LDS_TMP + 4096);
                const int t = (int)threadIdx.x;
                const unsigned* cnt = (const unsigned*)(ws + WS_CNT);
                int su[4], loc = 0;
#pragma unroll
                for (int k = 0; k < 4; ++k) { const unsigned cc = __hip_atomic_load(cnt + t * 4 + k, __ATOMIC_RELAXED, __HIP_MEMORY_SCOPE_AGENT); su[k] = loc; loc += (int)((cc + 255u) >> 8); cl[t * 4 + k] = (int)cc; }
                tmp[t] = loc; __syncthreads();
                for (int off = 1; off < NWAVES * 64; off <<= 1) { const int v = (t >= off) ? tmp[t - off] : 0; __syncthreads(); tmp[t] += v; __syncthreads(); }
                const int excl = tmp[t] - loc;
#pragma unroll
                for (int k = 0; k < 4; ++k) pre[t * 4 + k] = excl + su[k];
                if (t == NWAVES * 64 - 1) pre[2048] = tmp[t];
                __syncthreads();
                const int total = __builtin_amdgcn_readfirstlane(pre[2048]);
#define MOBA_UNIT(uu_, li_, k_, nv_, el_) do { int lo_ = 0, hi_ = 2047; \
                    while (lo_ < hi_) { const int mid_ = (lo_ + hi_ + 1) >> 1; const int pm_ = __builtin_amdgcn_readfirstlane(pre[mid_]); if (pm_ <= (uu_)) lo_ = mid_; else hi_ = mid_ - 1; } \
                    li_ = lo_; k_ = (uu_) - __builtin_amdgcn_readfirstlane(pre[lo_]); \
                    const int cc_ = __builtin_amdgcn_readfirstlane(cl[lo_]); \
                    nv_ = (cc_ - k_ * 256 < 256) ? (cc_ - k_ * 256) : 256; const int n_ = lo_ & 31; \
                    el_ = (const unsigned short*)(ws + WS_LIST) + (size_t)(lo_ >> 5) * 131072 + 256 * (31 * n_ - (n_ * (n_ - 1)) / 2) + k_ * 256; } while (0)
                int tq_ = (int)threadIdx.x; asm volatile("" : "+v"(tq_)); const int ri = (tq_ >> 6) * 32 + (tq_ & 31);
                int uu = vcu;
                if (uu < total) {
                    int li, k, nv; const unsigned short* el; MOBA_UNIT(uu, li, k, nv, el);
                    unsigned ent = (ri < nv) ? (unsigned)el[ri] : 0u;
                    for (;;) {
                        const int un = uu + G; const bool has = un < total;
                        int li2 = 0, k2 = 0, nv2 = 0; const unsigned short* el2 = el; unsigned ent2 = 0u;
                        if (has) { MOBA_UNIT(un, li2, k2, nv2, el2); ent2 = (ri < nv2) ? (unsigned)el2[ri] : 0u; }
                        const int n = li & 31, h = (li >> 5) & 15, b = li >> 9;
                        const size_t r0 = (size_t)b * SEQ;
                        attn_body::SpArgs sp{};
                        sp.el = el; sp.nvalid = nv; sp.nsel = 0; sp.h = h; sp.tok0 = (long)r0;
                        sp.d0 = (attn_body::bf16*)XN; sp.d1 = (attn_body::bf16*)hbuf; sp.d2 = ((attn_body::bf16*)hbuf + (size_t)T * 1024); sp.lse = (float*)(ws + WS_LSE);
#ifndef NO_A1
                        attn_body::attn_unit<4, 8>((const attn_body::bf16*)(QKV + r0 * 3072 + h * 64), (const attn_body::bf16*)(QKV + (r0 + n * 256) * 3072 + 1024 + h * 64),
                            (const attn_body::bf16*)(QKV + (r0 + n * 256) * 3072 + 2048 + h * 64), nullptr, 4, nullptr, 0.f, (char*)lds, sp, ent);
#endif
                        if (!has) break;
                        uu = un; li = li2; k = k2; nv = nv2; el = el2; ent = ent2;
                    }
                }
#undef MOBA_UNIT
            }
            xcd_barrier(bar);
            for (int uu = vcu; uu < NB * NH * 32; uu += G) {
                const int qb = uu & 31, h = (uu >> 5) & 15, b = uu >> 9;
                const size_t r0 = (size_t)b * SEQ, q0 = (size_t)qb * 256;
                attn_body::SpArgs sp{};
                sp.el = nullptr; sp.nvalid = 256; sp.nsel = qb < 3 ? qb : 3; sp.h = h; sp.tok0 = (long)(r0 + q0);
                sp.d0 = (attn_body::bf16*)XN; sp.d1 = (attn_body::bf16*)hbuf; sp.d2 = ((attn_body::bf16*)hbuf + (size_t)T * 1024); sp.lse = (float*)(ws + WS_LSE);
#ifndef NO_A1
                attn_body::attn_unit<5, 8>((const attn_body::bf16*)(QKV + (r0 + q0) * 3072 + h * 64), (const attn_body::bf16*)(QKV + (r0 + q0) * 3072 + 1024 + h * 64),
                    (const attn_body::bf16*)(QKV + (r0 + q0) * 3072 + 2048 + h * 64), nullptr, 4, nullptr, 0.f, (char*)lds, sp);
#endif
            }
            xcd_barrier(bar);
        } else {
            for (int u = vcu; u < NB * 2 * 64 * 4; u += G) {
                const int p = u & 3, qk = (u >> 2) & 63, kvh = (u >> 8) & 1, b = u >> 9, h = kvh * 8 + 2 * p;
                const size_t r0 = (size_t)b * SEQ, q0 = (size_t)qk * 128, k0 = qk > 0 ? q0 - 128 : 0;
                attn_body::SpArgs sp{}; sp.nsel = qk > 0 ? 2 : 0;
#ifndef NO_A2
                attn_body::attn_unit<6, 8>((const attn_body::bf16*)(QKV + (r0 + q0) * 1280 + h * 64), (const attn_body::bf16*)(QKV + (r0 + k0) * 1280 + 1024 + kvh * 64),
                    (const attn_body::bf16*)(QKV + (r0 + k0) * 1280 + 1152 + kvh * 64), (attn_body::bf16*)(XN + (r0 + q0) * 1024 + h * 64), 4, (const unsigned*)(ARGS_IN(15) + h), 0.f, (char*)lds, sp);
#endif
            }
            xcd_barrier(bar);
        }
        {
            pg8::Gemm g{XN, Wout, T, DM, DM}; pg8::StaticOrder S; S.init(T, DM, G, bx);
            pg8::EpiRes<L == 0> E{XIN, HB, DM, RSQ};
            pg8::gemm_phase<pg8::EpiRes<L == 0>, pg8::StaticOrder, true, true>(ldsl, g, S, E);
        }
        xcd_barrier(bar);
        {
            pg8::Gemm g{HB, Wup, T, DFF, DM}; pg8::StaticOrder S; S.init(T, DFF, G, bx);
            pg8::EpiRelu2 E{U, DFF, RSQ};
            pg8::gemm_phase<pg8::EpiRelu2, pg8::StaticOrder, true, true>(ldsl, g, S, E);
        }
        xcd_barrier(bar);
        {
            pg8::Gemm g{U, Wdown, T, DM, DFF}; pg8::StaticOrder S; S.init(T, DM, G, bx);
            pg8::EpiRes<false> E{nullptr, HB, DM, RSQ};
            pg8::gemm_phase<pg8::EpiRes<false>, pg8::StaticOrder, true, true>(ldsl, g, S, E);
        }
        xcd_barrier(bar);
        if (L + 1 == DEPTH) { FRESH_LANE(); for (int m = gw; m < T; m += 2 * NGW) rms_rowb2_to_f32(HB + (size_t)m * DM, HB + (size_t)(m + NGW) * DM, ARGS_IN(19), hbuf + (size_t)m * DM, hbuf + (size_t)(m + NGW) * DM, lane); }
    }
}
#undef FRESH_LANE
#undef ARGS_IN
#undef ws
#undef XIN
#undef hbuf
#undef ROPE
#undef SEL
#undef KM
#undef XN
#undef QKV
#undef O2
#undef U
#undef HB
#undef RSQ
#undef Win
#undef Wout
#undef Wup
#undef Wdown

__global__ void __launch_bounds__(NWAVES * 64, 2) fwd_mega(Args args) {
    extern __shared__ __attribute__((aligned(16))) unsigned char lds[];
    cg::grid_group grid = cg::this_grid();
    int tid_ = threadIdx.x; asm volatile("" : "+v"(tid_)); const int tid = tid_, lane = tid & 63, wave = __builtin_amdgcn_readfirstlane(tid >> 6);
    const int G = gridDim.x, bx = blockIdx.x;
    const int vcu = (G % 8 == 0) ? (bx % 8) * (G / 8) + bx / 8 : bx;
    const int gw = vcu * NWAVES + wave, NGW = G * NWAVES;
    unsigned char* ws = args.ws;
    const float* x = args.in[0]; const int* positions = (const int*)args.in[1];
    float* hbuf = args.out;
    float* ROPE = (float*)(ws + WS_ROPE); unsigned* SEL = (unsigned*)(ws + WS_SEL); float* KM = (float*)(ws + WS_KM);
    bf16* XN = (bf16*)(ws + WS_XN); bf16* QKV = (bf16*)(ws + WS_QKV); bf16* O2 = (bf16*)(ws + WS_O2); bf16* U = (bf16*)(ws + WS_U);
    LAS unsigned char* ldsl = (LAS unsigned char*)lds;
    if (tid < 64) ((LAS unsigned*)(ldsl + LDSCTL_OFF))[tid] = 0u;
    unsigned* barw = (unsigned*)(ws + WS_CTL);
    __syncthreads();
    const XcdBarrier bar = xcd_barrier_post(barw, (volatile LAS unsigned*)(ldsl + LDSCTL_OFF + 32));

#ifndef NO_PRO
    {
        LAS float* scr = (LAS float*)(ldsl + wave * 16384);
        int base = 0;
#pragma unroll 1
        for (int id = 0; id < 16; ++id) {
            const int L = id >> 2, kind = id & 3;
            const float* W; const float* gk = nullptr; int K, N; size_t off;
            if (kind == 0) { K = DM; off = W_IN; gk = args.in[2] + L * DM;
                if (L == 1) { W = args.in[11]; N = 3072; } else if (L == 2) { W = args.in[13]; N = 1280; } else { W = args.in[4] + (size_t)(L == 3 ? 1 : 0) * DM * 3072; N = 3072; } }
            else if (kind == 1) { K = DM; N = DM; off = W_OUT;
                if (L == 1) W = args.in[12]; else if (L == 2) W = args.in[16]; else W = args.in[5] + (size_t)(L == 3 ? 1 : 0) * DM * DM; }
            else if (kind == 2) { K = DM; N = DFF; off = W_UP; W = args.in[17] + (size_t)L * DM * DFF; gk = args.in[3] + L * DM; }
            else { K = DFF; N = DM; off = W_DOWN; W = args.in[18] + (size_t)L * DFF * DM; }
            bf16* WT = (bf16*)(ws + WS_W + (size_t)L * W_LAYER + off);
            const int items = (K / 64) * (N / 32);
            int it = (gw - base) % NGW; if (it < 0) it += NGW;
            for (; it < items; it += NGW) transpose_item(W, gk, K, N, WT, scr, it, lane);
            base = (base + items) % NGW;
        }
        for (int idx = bx * (NWAVES * 64) + tid; idx < T * 8; idx += G * NWAVES * 64) {
            const int tok = idx >> 3, i = idx & 7;
            const float inv = exp2f(-(float)i * (0.125f * 18.931568569324174f));
            const double a = (double)((float)positions[tok] * inv);
            const double k = rint(a * 0.15915494309189535);
            const float r = (float)(a - k * 6.283185307179586);
            ROPE[(size_t)tok * 16 + i] = cosf(r); ROPE[(size_t)tok * 16 + 8 + i] = sinf(r);
        }
        for (int m = gw; m < T; m += NGW) row_to_bf16_sumsq(x + (size_t)m * DM, (bf16*)(ws + WS_HB) + (size_t)m * DM, (float*)(ws + WS_RSQ) + (size_t)m * 16, lane);
    }
#endif
    if (args.out == nullptr) grid.sync();
    xcd_barrier(bar);

    layer_fwd<0>(lds, bar); layer_fwd<1>(lds, bar); layer_fwd<2>(lds, bar); layer_fwd<3>(lds, bar);
}

extern "C" void kernel_launch(void* const* d_in, const int* in_sizes, int n_in, void* d_out, int out_size, void* d_ws, size_t ws_size, hipStream_t stream) {
    static int grid = 0;
    if (grid == 0) {
        int dev = 0, cus = 0, per_cu = 0;
        if (n_in != 20 || out_size != T * DM || ws_size < WS_END) { fprintf(stderr, "kernel_launch: unexpected problem (n_in %d out %d ws %zu)\n", n_in, out_size, ws_size); grid = -1; return; }
        (void)hipGetDevice(&dev);
        (void)hipDeviceGetAttribute(&cus, hipDeviceAttributeMultiprocessorCount, dev);
        (void)hipFuncSetAttribute((const void*)fwd_mega, hipFuncAttributeMaxDynamicSharedMemorySize, LDS_BYTES);
        (void)hipOccupancyMaxActiveBlocksPerMultiprocessor(&per_cu, (const void*)fwd_mega, NWAVES * 64, LDS_BYTES);
        (void)hipGetLastError();
        grid = cus;
    }
    if (grid < 0) return;
    Args a{};
    for (int i = 0; i < 20; ++i) a.in[i] = (const float*)d_in[i];
    a.out = (float*)d_out; a.ws = (unsigned char*)d_ws;
    void* kargs[] = {&a};
    (void)hipMemsetAsync((unsigned char*)d_ws + WS_CTL, 0, 16384, stream);
    hipError_t e = hipLaunchCooperativeKernel((void*)fwd_mega, dim3(grid), dim3(NWAVES * 64), kargs, LDS_BYTES, stream);
    if (e != hipSuccess) fprintf(stderr, "cooperative launch failed: %s (grid %d)\n", hipGetErrorString(e), grid);
}
```

```cpp
#include <hip/hip_runtime.h>
#include <hip/hip_cooperative_groups.h>
#include <hip/hip_bf16.h>
#include <cstdio>
#include <cstdint>
#include <cmath>
namespace cg = cooperative_groups;
namespace pg8 {
#define PG8_LAS __attribute__((address_space(3)))
typedef unsigned short bf16_t;
typedef short bf16x8 __attribute__((ext_vector_type(8)));
typedef float f32x4 __attribute__((ext_vector_type(4)));
typedef unsigned u32x4 __attribute__((ext_vector_type(4)));
constexpr int BM = 256, BK = 64, HALF = 128, HTB = HALF * BK * 2  , STAGE_BYTES = 8 * HTB, NXCD = 8, WGM = 8;

__host__ __device__ __forceinline__ int lds_byte(int r, int c) { const int st = (r >> 4) * 2 + (c >> 5), rr = r & 15, cc = c & 31, ob = rr * 64 + cc * 2; return st * 1024 + (ob ^ (((ob >> 9) & 1) << 5)); }
__host__ __device__ __forceinline__ void stage_rc(int b, int& R, int& C) { const int st = b / 1024, sb = b % 1024, swz = sb ^ (((sb >> 9) & 1) << 5); R = (st >> 1) * 16 + swz / 64; C = (st & 1) * 32 + (swz % 64) / 2; }
__host__ __device__ __forceinline__ int perm32(int rho) { const int n = rho >> 4, i = rho & 15; return 8 * (i >> 2) + 4 * n + (i & 3); }

struct Unit { int pm, pn; };
struct Gemm { const bf16_t* A; const bf16_t* Bt; int M, N, K; };

struct StaticOrder {
    int nM, nN, nwg, G, c;
    __host__ __device__ void init(int M, int N, int G_, int c_) { nM = M / BM; nN = N / BM; nwg = nM * nN; G = G_; c = c_; }
    __host__ __device__ bool next(int i, Unit& u) const {
        const long L = (long)i * G + c; if (L >= nwg) return false;
        int wgid = (int)L; { const int q = nwg / NXCD, r = nwg % NXCD, xcd = wgid % NXCD, off = wgid / NXCD; wgid = (xcd < r ? xcd * (q + 1) : r * (q + 1) + (xcd - r) * q) + off; }
        const int nig = WGM * nN, gid = wgid / nig, fm = gid * WGM, gsz = (nM - fm) < WGM ? (nM - fm) : WGM;
        u.pm = fm + ((wgid % nig) % gsz); u.pn = (wgid % nig) / gsz; return true;
    }
    __device__ __forceinline__ void a_ready(const Unit&) const {}
    __device__ __forceinline__ void done(const Unit&) const {}
};

__device__ __forceinline__ unsigned cvt_pk_bf16(float lo, float hi) { unsigned r; asm volatile("v_cvt_pk_bf16_f32 %0, %1, %2" : "=v"(r) : "v"(lo), "v"(hi)); return r; }
typedef float f32x2 __attribute__((ext_vector_type(2)));
__device__ __forceinline__ f32x2 gelu_pk(f32x2 v) {
    const f32x2 av = __builtin_elementwise_abs(v), d = av * 0.2316418882f + 1.0f;
    f32x2 t; t.x = __builtin_amdgcn_rcpf(d.x); t.y = __builtin_amdgcn_rcpf(d.y);
    f32x2 q = t * 0.5307027145f + (-0.7265760135f); q = q * t + 0.7107068705f; q = q * t + (-0.142248368f); q = q * t + 0.127414796f; q = q * t;
    const f32x2 s = (v * v) * (-0.72134752044f);
    f32x2 e; e.x = __builtin_amdgcn_exp2f(s.x); e.y = __builtin_amdgcn_exp2f(s.y);
    const f32x2 m = v * (q * e), r = v - m;
    f32x2 o; o.x = v.x < 0.f ? m.x : r.x; o.y = v.y < 0.f ? m.y : r.y; return o;
}

template <int ACT  > struct EpiBf16 {
    static constexpr bool PERM = true, AFTER_DRAIN = false; static_assert(ACT == 0 || ACT == 1, "EpiBf16: ACT is 0 (none) or 1 (gelu_pk)");
    bf16_t* O; int ldc; const float* bias; int split_cols; size_t split_stride; float scale0;
    __device__ __forceinline__ void operator()(const f32x4 (&acc)[2][2][4][2], const Unit& u, int wr, int wc, int fr, int fq) const {
        const int row0 = u.pm * BM + wr * 64 + fr; int colt = u.pn * BM; bf16_t* base = O;
        float sc = 1.f; if (split_cols) { const int t = colt / split_cols; base += (size_t)t * split_stride; colt -= t * split_cols; if (t == 0) sc = scale0; }
        const int col0 = colt + wc * 32 + 8 * fq, bcol0 = u.pn * BM + wc * 32 + 8 * fq;
        f32x4 bv[2][2];
#pragma unroll
        for (int bj = 0; bj < 2; ++bj)
#pragma unroll
            for (int n = 0; n < 2; ++n) bv[bj][n] = bias ? *(const f32x4*)(bias + bcol0 + bj * HALF + 4 * n) : (f32x4){0.f, 0.f, 0.f, 0.f};
#pragma unroll
        for (int ai = 0; ai < 2; ++ai)
#pragma unroll
            for (int m = 0; m < 4; ++m) { bf16_t* rowp = base + (size_t)(row0 + ai * HALF + m * 16) * ldc + col0;
#pragma unroll
                for (int bj = 0; bj < 2; ++bj) { f32x4 v0 = acc[ai][bj][m][0] + bv[bj][0], v1 = acc[ai][bj][m][1] + bv[bj][1];
                    if (ACT == 1) { f32x2 a = gelu_pk((f32x2){v0[0], v0[1]}), b = gelu_pk((f32x2){v0[2], v0[3]}), c = gelu_pk((f32x2){v1[0], v1[1]}), d = gelu_pk((f32x2){v1[2], v1[3]});
                        v0 = (f32x4){a.x, a.y, b.x, b.y}; v1 = (f32x4){c.x, c.y, d.x, d.y}; }
                    v0 = v0 * sc; v1 = v1 * sc; u32x4 w; w.x = cvt_pk_bf16(v0[0], v0[1]); w.y = cvt_pk_bf16(v0[2], v0[3]); w.z = cvt_pk_bf16(v1[0], v1[1]); w.w = cvt_pk_bf16(v1[2], v1[3]);
                    *(u32x4*)(rowp + bj * HALF) = w; } }
    }
};

__device__ __forceinline__ float xrow16_sum(float x) {
    auto s = __builtin_amdgcn_permlane16_swap(__float_as_uint(x), __float_as_uint(x), false, false);
    x = __uint_as_float(s[0]) + __uint_as_float(s[1]);
    auto t = __builtin_amdgcn_permlane32_swap(__float_as_uint(x), __float_as_uint(x), false, false);
    return __uint_as_float(t[0]) + __uint_as_float(t[1]);
}
__device__ __forceinline__ float xor16(float x) {
    auto s = __builtin_amdgcn_permlane16_swap(__float_as_uint(x), __float_as_uint(x), false, false);
    return __uint_as_float(s[0] ^ s[1] ^ __float_as_uint(x));
}
template <int NR> __device__ __forceinline__ void row_rstd(float (&rstd)[NR], const float* rsq, int rowb, int fq) {
    f32x4 q[NR];
#pragma unroll
    for (int i = 0; i < NR; ++i) q[i] = *(const f32x4*)(rsq + (size_t)(rowb + i * 16) * 16 + fq * 4);
#pragma unroll
    for (int i = 0; i < NR; ++i) { const float t = xrow16_sum((q[i][0] + q[i][1]) + (q[i][2] + q[i][3])); rstd[i] = __builtin_amdgcn_rsqf(t * (1.0f / 1024.0f) + 1e-6f); }
}
__device__ __forceinline__ u32x4 dpp_xor1(u32x4 v) { u32x4 r;
#pragma unroll
    for (int e = 0; e < 4; ++e) r[e] = (unsigned)__builtin_amdgcn_mov_dpp((int)v[e], 0xB1, 0xf, 0xf, true);
    return r; }
struct EpiQKV {
    static constexpr bool PERM = true, AFTER_DRAIN = false, WIDE = true;
    bf16_t* O; int ldc; const float* bias; const float* rope; int rope_cols, q_cols; float qscale; const float* rsq;
    __device__ __forceinline__ void operator()(const f32x4 (&acc)[2][2][4][2], const Unit& u, int wr, int wc, int fr, int fq) const {
        const int row0 = u.pm * BM + wr * 64 + fr, odd = fr & 1;
        const int colw = u.pn * BM + wc * 64;
        const bool do_rope = colw < rope_cols;
        const bool rl = do_rope && (fq < 2);
        const float sgn = (fq == 0) ? -1.f : 1.f;
        const float sc = (colw < q_cols) ? qscale : 1.f;
        f32x4 bv[2][2];
#pragma unroll
        for (int bj = 0; bj < 2; ++bj) { const int col0 = colw + bj * 32 + 8 * fq;
            bv[bj][0] = bias ? *(const f32x4*)(bias + col0) : (f32x4){0.f, 0.f, 0.f, 0.f}; bv[bj][1] = bias ? *(const f32x4*)(bias + col0 + 4) : (f32x4){0.f, 0.f, 0.f, 0.f}; }
        const int colA = colw + odd * 32 + 8 * fq;
        float rstd[2][4]; row_rstd<4>(rstd[0], rsq, row0, fq); row_rstd<4>(rstd[1], rsq, row0 + HALF, fq);
        f32x4 cs[8][4];
#define EPIQKV_LOAD(k_) do { \
            cs[k_][0] = (f32x4){1.f, 1.f, 1.f, 1.f}; cs[k_][1] = cs[k_][0]; cs[k_][2] = (f32x4){0.f, 0.f, 0.f, 0.f}; cs[k_][3] = cs[k_][2]; \
            if (rl) { const f32x4* rp = (const f32x4*)(rope + (size_t)(row0 + ((k_) >> 2) * HALF + ((k_) & 3) * 16) * 16); cs[k_][0] = rp[0]; cs[k_][1] = rp[1]; cs[k_][2] = rp[2]; cs[k_][3] = rp[3]; } } while (0)
        EPIQKV_LOAD(0);
#pragma unroll
        for (int k = 0; k < 8; ++k) { const int ai = k >> 2, m = k & 3;
            if (k + 1 < 8) EPIQKV_LOAD(k + 1);
            const int row = row0 + ai * HALF + m * 16;
            u32x4 w[2];
#pragma unroll
            for (int bj = 0; bj < 2; ++bj) {
                f32x4 v0 = acc[ai][bj][m][0] * rstd[ai][m] + bv[bj][0], v1 = acc[ai][bj][m][1] * rstd[ai][m] + bv[bj][1];
                if (bj == 0 && do_rope) {
                    f32x4 p0, p1;
#pragma unroll
                    for (int e = 0; e < 4; ++e) { p0[e] = xor16(v0[e]); p1[e] = xor16(v1[e]); }
                    if (rl) { v0 = v0 * cs[k][0] + (p0 * cs[k][2]) * sgn; v1 = v1 * cs[k][1] + (p1 * cs[k][3]) * sgn; }
                }
                v0 = v0 * sc; v1 = v1 * sc;
                w[bj].x = cvt_pk_bf16(v0[0], v0[1]); w[bj].y = cvt_pk_bf16(v0[2], v0[3]); w[bj].z = cvt_pk_bf16(v1[0], v1[1]); w[bj].w = cvt_pk_bf16(v1[2], v1[3]);
            }
            const u32x4 rcv = dpp_xor1(odd ? w[0] : w[1]);
            const u32x4 s1 = odd ? rcv : w[0], s2 = odd ? w[1] : rcv;
            bf16_t* rp = O + (size_t)(row - odd) * ldc + colA;
            *(u32x4*)rp = s1; *(u32x4*)(rp + ldc) = s2;
        }
#undef EPIQKV_LOAD
    }
};
struct EpiRelu2 {
    static constexpr bool PERM = true, AFTER_DRAIN = false, WIDE = true;
    bf16_t* O; int ldc; const float* rsq;
    __device__ __forceinline__ void operator()(const f32x4 (&acc)[2][2][4][2], const Unit& u, int wr, int wc, int fr, int fq) const {
        const int row0 = u.pm * BM + wr * 64 + fr, odd = fr & 1;
        const int colA = u.pn * BM + wc * 64 + odd * 32 + 8 * fq;
        float rstd[2][4]; row_rstd<4>(rstd[0], rsq, row0, fq); row_rstd<4>(rstd[1], rsq, row0 + HALF, fq);
#pragma unroll
        for (int ai = 0; ai < 2; ++ai) {
#pragma unroll
            for (int m = 0; m < 4; ++m) { const int row = row0 + ai * HALF + m * 16;
                u32x4 w[2];
#pragma unroll
                for (int bj = 0; bj < 2; ++bj) { f32x4 v0 = acc[ai][bj][m][0] * rstd[ai][m], v1 = acc[ai][bj][m][1] * rstd[ai][m];
#pragma unroll
                    for (int e = 0; e < 4; ++e) { const float a = fmaxf(v0[e], 0.f), b = fmaxf(v1[e], 0.f); v0[e] = a * a; v1[e] = b * b; }
                    w[bj].x = cvt_pk_bf16(v0[0], v0[1]); w[bj].y = cvt_pk_bf16(v0[2], v0[3]); w[bj].z = cvt_pk_bf16(v1[0], v1[1]); w[bj].w = cvt_pk_bf16(v1[2], v1[3]); }
                u32x4 snd, rcv;
#pragma unroll
                for (int e = 0; e < 4; ++e) { snd[e] = odd ? w[0][e] : w[1][e]; rcv[e] = (unsigned)__builtin_amdgcn_mov_dpp((int)snd[e], 0xB1, 0xf, 0xf, true); }
                u32x4 s1, s2;
#pragma unroll
                for (int e = 0; e < 4; ++e) { s1[e] = odd ? rcv[e] : w[0][e]; s2[e] = odd ? w[1][e] : rcv[e]; }
                bf16_t* rp = O + (size_t)(row - odd) * ldc + colA;
                *(u32x4*)rp = s1; *(u32x4*)(rp + ldc) = s2; } }
    }
};
template <bool F32BASE> struct EpiRes {
    static constexpr bool PERM = true, AFTER_DRAIN = false, WIDE = true;
    const float* basef; bf16_t* hb; int ldc; float* rsq;
    __device__ __forceinline__ void operator()(const f32x4 (&acc)[2][2][4][2], const Unit& u, int wr, int wc, int fr, int fq) const {
        const int row0 = u.pm * BM + wr * 64 + fr, odd = fr & 1;
        const int colw = u.pn * BM + wc * 64, colA = colw + odd * 32 + 8 * fq;
        f32x4 bf[F32BASE ? 4 : 1][2][2][2]; u32x4 bb[F32BASE ? 1 : 4][2][2];
#define EPIRES_LOAD(am_) do { _Pragma("unroll") for (int mi = 0; mi < 2; ++mi) { const int row_ = row0 + ((am_) >> 1) * HALF + (((am_) & 1) * 2 + mi) * 16; \
            if (F32BASE) { _Pragma("unroll") for (int bj = 0; bj < 2; ++bj) { const float* p_ = basef + (size_t)row_ * ldc + colw + bj * 32 + 8 * fq; bf[F32BASE ? (am_) : 0][mi][bj][0] = *(const f32x4*)p_; bf[F32BASE ? (am_) : 0][mi][bj][1] = *(const f32x4*)(p_ + 4); } } \
            else { const bf16_t* p_ = hb + (size_t)(row_ - odd) * ldc + colA; bb[F32BASE ? 0 : (am_)][mi][0] = *(const u32x4*)p_; bb[F32BASE ? 0 : (am_)][mi][1] = *(const u32x4*)(p_ + ldc); } } } while (0)
        EPIRES_LOAD(0);
#pragma unroll
        for (int am = 0; am < 4; ++am) { const int ai = am >> 1;
            if (am + 1 < 4) EPIRES_LOAD(am + 1);
#pragma unroll
            for (int mi = 0; mi < 2; ++mi) { const int m = (am & 1) * 2 + mi; const int row = row0 + ai * HALF + m * 16; float ss = 0.f;
                u32x4 own[2];
                if (!F32BASE) { const u32x4 l1 = bb[F32BASE ? 0 : am][mi][0], l2 = bb[F32BASE ? 0 : am][mi][1]; const u32x4 rcv = dpp_xor1(odd ? l1 : l2); own[0] = odd ? rcv : l1; own[1] = odd ? l2 : rcv; }
                u32x4 w[2];
#pragma unroll
                for (int bj = 0; bj < 2; ++bj) {
                    f32x4 b0, b1;
                    if (F32BASE) { b0 = bf[F32BASE ? am : 0][mi][bj][0]; b1 = bf[F32BASE ? am : 0][mi][bj][1]; }
                    else { const u32x4 q = own[bj];
                        b0 = (f32x4){__uint_as_float(q.x << 16), __uint_as_float(q.x & 0xffff0000u), __uint_as_float(q.y << 16), __uint_as_float(q.y & 0xffff0000u)};
                        b1 = (f32x4){__uint_as_float(q.z << 16), __uint_as_float(q.z & 0xffff0000u), __uint_as_float(q.w << 16), __uint_as_float(q.w & 0xffff0000u)}; }
                    const f32x4 v0 = b0 + acc[ai][bj][m][0], v1 = b1 + acc[ai][bj][m][1];
                    ss += ((v0[0] * v0[0] + v0[1] * v0[1]) + (v0[2] * v0[2] + v0[3] * v0[3])) + ((v1[0] * v1[0] + v1[1] * v1[1]) + (v1[2] * v1[2] + v1[3] * v1[3]));
                    w[bj].x = cvt_pk_bf16(v0[0], v0[1]); w[bj].y = cvt_pk_bf16(v0[2], v0[3]); w[bj].z = cvt_pk_bf16(v1[0], v1[1]); w[bj].w = cvt_pk_bf16(v1[2], v1[3]); }
                const u32x4 rcv2 = dpp_xor1(odd ? w[0] : w[1]);
                const u32x4 s1 = odd ? rcv2 : w[0], s2 = odd ? w[1] : rcv2;
                bf16_t* rp = hb + (size_t)(row - odd) * ldc + colA;
                *(u32x4*)rp = s1; *(u32x4*)(rp + ldc) = s2;
                ss = xrow16_sum(ss);
                if (fq == 0) rsq[(size_t)row * 16 + u.pn * 4 + wc] = ss; }
        }
#undef EPIRES_LOAD
    }
};
template <class Epi, class Sched, bool ALIGN_EPI = false, bool SP2 = false>
__device__ __forceinline__ void gemm_phase(PG8_LAS unsigned char* lds, const Gemm g, const Sched& S, const Epi& E) {
    int tid_ = threadIdx.x; asm volatile("" : "+v"(tid_));
    const int tid = tid_, wid = __builtin_amdgcn_readfirstlane(tid >> 6), lane = tid & 63, wr = wid >> 2, wc = wid & 3, fr = lane & 15, fq = lane >> 4;
    const int K = g.K, nt = K / BK;
    unsigned voffA[2], voffB[2];
#pragma unroll
    for (int i = 0; i < 2; ++i) { int R, C; stage_rc(tid * 16 + i * 8192, R, C); const int Rb = Epi::WIDE ? (64 * (R >> 5) + perm32(R & 31)) : (Epi::PERM ? ((R & ~31) + perm32(R & 31)) : R);
        voffA[i] = (unsigned)(R * K + C) * 2u; voffB[i] = (unsigned)(Rb * K + C) * 2u; }
    const size_t kstep = (size_t)(BK * 2);
    const size_t hstep = (size_t)HALF * K * 2;
    const size_t hstepB = Epi::WIDE ? (size_t)32 * K * 2 : hstep;
    const size_t tstep = 2 * hstep;
    const unsigned ldsw = (unsigned)wid * 1024u;
    const int aoff = lds_byte(wr * 64 + fr, fq * 8), boff = lds_byte(wc * 32 + fr, fq * 8);
#define PG8_SA(b, h) (((b) * 2 + (h)) * HTB)
#define PG8_SB(b, h) ((4 + (b) * 2 + (h)) * HTB)
#define PG8_STAGE(bufoff, gbase, voff) do { _Pragma("unroll") for (int _i = 0; _i < 2; ++_i) \
        __builtin_amdgcn_global_load_lds((const unsigned*)((const char*)(gbase) + (voff)[_i]), (PG8_LAS unsigned*)(lds + (bufoff) + ldsw + _i * 8192), 16, 0, 0); } while (0)
#define PG8_LDA(dst, b, h) do { _Pragma("unroll") for (int m = 0; m < 4; ++m) _Pragma("unroll") for (int k = 0; k < 2; ++k) dst[m][k] = *(const PG8_LAS bf16x8*)(lds + PG8_SA(b, h) + aoff + m * 2048 + k * 1024); } while (0)
#define PG8_LDB(dst, b, h) do { _Pragma("unroll") for (int n = 0; n < 2; ++n) _Pragma("unroll") for (int k = 0; k < 2; ++k) dst[n][k] = *(const PG8_LAS bf16x8*)(lds + PG8_SB(b, h) + boff + n * 2048 + k * 1024); } while (0)
#define PG8_MMA(ai, bj, At, Bt) do { __builtin_amdgcn_s_setprio(1); _Pragma("unroll") for (int m = 0; m < 4; ++m) _Pragma("unroll") for (int n = 0; n < 2; ++n) _Pragma("unroll") for (int k = 0; k < 2; ++k) \
        acc[ai][bj][m][n] = __builtin_amdgcn_mfma_f32_16x16x32_bf16(Bt[n][k], At[m][k], acc[ai][bj][m][n], 0, 0, 0); __builtin_amdgcn_s_setprio(0); } while (0)
#define PG8_WAIT_V(n) asm volatile("s_waitcnt vmcnt(" #n ")" ::: "memory")
#define PG8_WAIT_L(n) asm volatile("s_waitcnt lgkmcnt(" #n ")" ::: "memory")
#define PG8_BAR __builtin_amdgcn_s_barrier()
#define PG8_SCHED __builtin_amdgcn_sched_barrier(0)
    Unit cur, nxt; int ui = 0;
    if (!S.next(0, cur)) return;
    f32x4 acc[2][2][4][2];
#pragma unroll
    for (int a = 0; a < 2; ++a)
#pragma unroll
        for (int b = 0; b < 2; ++b)
#pragma unroll
            for (int m = 0; m < 4; ++m)
#pragma unroll
                for (int n = 0; n < 2; ++n) acc[a][b][m][n] = (f32x4){0.f, 0.f, 0.f, 0.f};
    bf16x8 At[4][2], B0[2][2], B1[2][2];
    const char* cA = (const char*)g.A + (size_t)cur.pm * tstep; const char* cB = (const char*)g.Bt + (size_t)cur.pn * tstep;
    S.a_ready(cur);
    if constexpr (SP2) {
        PG8_STAGE(PG8_SB(0, 0), cB, voffB); PG8_STAGE(PG8_SB(0, 1), cB + hstepB, voffB); PG8_STAGE(PG8_SA(0, 0), cA, voffA); PG8_STAGE(PG8_SA(0, 1), cA + hstep, voffA);
        if (wr == 1) PG8_BAR;
        PG8_WAIT_V(2); PG8_BAR;
        PG8_STAGE(PG8_SB(1, 0), cB + kstep, voffB); PG8_STAGE(PG8_SA(1, 0), cA + kstep, voffA); PG8_STAGE(PG8_SB(1, 1), cB + hstepB + kstep, voffB);
        PG8_WAIT_V(6); PG8_BAR;
    } else {
        PG8_STAGE(PG8_SB(0, 0), cB, voffB); PG8_STAGE(PG8_SA(0, 0), cA, voffA); PG8_STAGE(PG8_SB(0, 1), cB + hstepB, voffB); PG8_STAGE(PG8_SA(0, 1), cA + hstep, voffA);
        if (wr == 1) PG8_BAR;
        PG8_WAIT_V(4); PG8_BAR;
        PG8_STAGE(PG8_SB(1, 0), cB + kstep, voffB); PG8_STAGE(PG8_SA(1, 0), cA + kstep, voffA); PG8_STAGE(PG8_SB(1, 1), cB + hstepB + kstep, voffB);
        PG8_WAIT_V(6); PG8_BAR;
    }
    for (;;) {
        const bool has_next = S.next(ui + 1, nxt);
        const char* nA = has_next ? (const char*)g.A + (size_t)nxt.pm * tstep : cA; const char* nB = has_next ? (const char*)g.Bt + (size_t)nxt.pn * tstep : cB;
        for (int t = 0; t < nt; t += 2) {
            const bool last = (t == nt - 2);
            const char* a1 = cA + (size_t)(t + 1) * kstep;
            const char* a2 = last ? nA : cA + (size_t)(t + 2) * kstep; const char* b2 = last ? nB : cB + (size_t)(t + 2) * kstep;
            const char* a3 = a2 + kstep; const char* b3 = b2 + kstep;
            if (last && has_next) S.a_ready(nxt);
            if constexpr (SP2) {
            PG8_LDB(B0, 0, 0); PG8_LDB(B1, 0, 1); PG8_SCHED; PG8_LDA(At, 0, 0); PG8_STAGE(PG8_SA(1, 1), a1 + hstep, voffA);
            PG8_WAIT_V(8); PG8_WAIT_L(0); PG8_BAR; PG8_MMA(0, 0, At, B0); PG8_MMA(0, 1, At, B1); PG8_BAR; PG8_SCHED;
            PG8_LDA(At, 0, 1); PG8_STAGE(PG8_SB(0, 0), b2, voffB); PG8_STAGE(PG8_SB(0, 1), b2 + hstepB, voffB); PG8_STAGE(PG8_SA(0, 0), a2, voffA);
            PG8_WAIT_V(8); PG8_WAIT_L(0); PG8_BAR; PG8_MMA(1, 0, At, B0); PG8_MMA(1, 1, At, B1); PG8_BAR; PG8_SCHED;
            PG8_LDB(B0, 1, 0); PG8_LDB(B1, 1, 1); PG8_SCHED; PG8_LDA(At, 1, 0); PG8_STAGE(PG8_SA(0, 1), a2 + hstep, voffA);
            PG8_WAIT_V(8); PG8_WAIT_L(0); PG8_BAR; PG8_MMA(0, 0, At, B0); PG8_MMA(0, 1, At, B1); PG8_BAR; PG8_SCHED;
            PG8_LDA(At, 1, 1); PG8_STAGE(PG8_SB(1, 0), b3, voffB); PG8_STAGE(PG8_SB(1, 1), b3 + hstepB, voffB); PG8_STAGE(PG8_SA(1, 0), a3, voffA);
            PG8_WAIT_V(8); PG8_WAIT_L(0); PG8_BAR; PG8_MMA(1, 0, At, B0); PG8_MMA(1, 1, At, B1); PG8_BAR; PG8_SCHED;
            } else {
            PG8_LDB(B0, 0, 0); PG8_SCHED; PG8_LDA(At, 0, 0); PG8_STAGE(PG8_SA(1, 1), a1 + hstep, voffA);
            PG8_WAIT_L(8); PG8_BAR; PG8_WAIT_L(0); PG8_MMA(0, 0, At, B0); PG8_BAR; PG8_SCHED;
            PG8_LDB(B1, 0, 1); PG8_STAGE(PG8_SB(0, 0), b2, voffB);
            PG8_BAR; PG8_WAIT_L(0); PG8_MMA(0, 1, At, B1); PG8_BAR;
            PG8_LDA(At, 0, 1); PG8_STAGE(PG8_SA(0, 0), a2, voffA);
            PG8_BAR; PG8_WAIT_L(0); PG8_MMA(1, 0, At, B0); PG8_BAR; PG8_SCHED;
            PG8_STAGE(PG8_SB(0, 1), b2 + hstepB, voffB);
            PG8_WAIT_V(6); PG8_BAR; PG8_MMA(1, 1, At, B1); PG8_BAR;
            PG8_LDB(B0, 1, 0); PG8_SCHED; PG8_LDA(At, 1, 0); PG8_STAGE(PG8_SA(0, 1), a2 + hstep, voffA);
            PG8_WAIT_L(8); PG8_BAR; PG8_WAIT_L(0); PG8_MMA(0, 0, At, B0); PG8_BAR; PG8_SCHED;
            PG8_LDB(B1, 1, 1); PG8_STAGE(PG8_SB(1, 0), b3, voffB);
            PG8_BAR; PG8_WAIT_L(0); PG8_MMA(0, 1, At, B1); PG8_BAR;
            PG8_LDA(At, 1, 1); PG8_STAGE(PG8_SA(1, 0), a3, voffA);
            PG8_BAR; PG8_WAIT_L(0); PG8_MMA(1, 0, At, B0); PG8_BAR; PG8_SCHED;
            PG8_STAGE(PG8_SB(1, 1), b3 + hstepB, voffB);
            PG8_WAIT_V(6); PG8_BAR; PG8_MMA(1, 1, At, B1); PG8_BAR;
            }
        }
        if constexpr (ALIGN_EPI) { if (wr == 0) PG8_BAR; }
        if constexpr (!Epi::AFTER_DRAIN) { E(acc, cur, wr, wc, fr, fq); S.done(cur); }
        if (!has_next) break;
#pragma unroll
        for (int a = 0; a < 2; ++a)
#pragma unroll
            for (int b = 0; b < 2; ++b)
#pragma unroll
                for (int m = 0; m < 4; ++m)
#pragma unroll
                    for (int n = 0; n < 2; ++n) acc[a][b][m][n] = (f32x4){0.f, 0.f, 0.f, 0.f};
        cur = nxt; cA = nA; cB = nB; ++ui;
        if constexpr (ALIGN_EPI) { if (wr == 1) PG8_BAR; }
    }
    PG8_WAIT_V(0);
    if constexpr (!ALIGN_EPI) { if (wr == 0) PG8_BAR; }
    PG8_BAR;
    if constexpr (Epi::AFTER_DRAIN) { E.fused(acc, cur, wr, wc, fr, fq, lds, wid, lane); S.done(cur); }
#undef PG8_SA
#undef PG8_SB
#undef PG8_STAGE
#undef PG8_LDA
#undef PG8_LDB
#undef PG8_MMA
#undef PG8_WAIT_V
#undef PG8_WAIT_L
#undef PG8_BAR
#undef PG8_SCHED
}
}
namespace attn_body {
using bf16=__hip_bfloat16;
using bf16x8=__attribute__((ext_vector_type(8)))short;
using s16x4=__attribute__((ext_vector_type(4)))short;
using f32x16=__attribute__((ext_vector_type(16)))float;
using u32x4=__attribute__((ext_vector_type(4)))unsigned;
constexpr int D=64;
constexpr int NW=8,QBLK=32,QB=QBLK*NW,KVBLK=64;
constexpr int ATTN_UNIT_ROWS=QB;
__device__ __forceinline__ int crow(int r,int hi){return (r&3)+8*(r>>2)+4*hi;}
#define SBAR() __builtin_amdgcn_sched_barrier(0)
__device__ __forceinline__ void cmask(f32x16&p0,f32x16&p1,int jb,int qrel,int hi){
  const float NEG=-INFINITY; int kb=64*jb+4*hi;
  #pragma unroll
  for(int r=0;r<16;++r){int kv=kb+(r&3)+8*(r>>2); if(kv>qrel)p0[r]=NEG; if(kv+32>qrel)p1[r]=NEG;}
}
template<int MODE> __device__ __forceinline__ void xmask(f32x16&p0,f32x16&p1,int t,int NT,int qrel,int hi,unsigned selm){
  const float NEG=-INFINITY; const int jb=t-(NT-4);
  if(MODE==4){ }
  else if(MODE==0||MODE==3||MODE==5){ if(jb>=0)cmask(p0,p1,jb,qrel,hi); }
  else if(MODE==1){ if(jb>=0)cmask(p0,p1,jb,qrel,hi); else if(!((selm>>(t>>2))&1u)){
      #pragma unroll
      for(int r=0;r<16;++r){p0[r]=NEG;p1[r]=NEG;} } }
  else{ const int kb=64*jb+4*hi;
    #pragma unroll
    for(int r=0;r<16;++r){int kv=kb+(r&3)+8*(r>>2); if(kv>qrel||kv<=qrel-128)p0[r]=NEG; if(kv+32>qrel||kv+32<=qrel-128)p1[r]=NEG;} }
}

constexpr int NSLOT=3, SLOTB=8192;
constexpr int LDS_K=0, LDS_V=NSLOT*SLOTB, LDS_WS=2*NSLOT*SLOTB, LDS_OST=LDS_WS+NW*64*4, LDS_BYTES=LDS_OST+NW*4096, LDS_V2=86016, V2OFF=LDS_V2-LDS_V;
constexpr float C2=0.125f*1.4426950408889634f;
__device__ __forceinline__ void glds16(const void*gsrc,unsigned lds_dst){unsigned keep;
  asm volatile("s_mov_b32 %0, m0\n\ts_mov_b32 m0, %2\n\ts_nop 0\n\tglobal_load_lds_dwordx4 %1, off\n\ts_mov_b32 m0, %0":"=&s"(keep):"v"(gsrc),"s"(lds_dst):"memory");}
__device__ __forceinline__ void glds16s(const void*sbase,unsigned voff,unsigned lds_dst){unsigned keep;
  asm volatile("s_mov_b32 %0, m0\n\ts_mov_b32 m0, %3\n\ts_nop 0\n\tglobal_load_lds_dwordx4 %1, %2\n\ts_mov_b32 m0, %0":"=&s"(keep):"v"(voff),"s"(sbase),"s"(lds_dst):"memory");}
__device__ __forceinline__ float max3f(float a,float b,float c){float r;asm("v_max3_f32 %0, %1, %2, %3":"=v"(r):"v"(a),"v"(b),"v"(c));return r;}
__device__ __forceinline__ float max2f(float a,float b){float r;asm("v_max_f32_e32 %0, %1, %2":"=v"(r):"v"(a),"v"(b));return r;}
__device__ __forceinline__ float fadd_s(float a,float b){float r;asm("v_add_f32_e32 %0, %1, %2":"=v"(r):"v"(a),"v"(b));return r;}
__device__ __forceinline__ float fsub_s(float a,float b){float r;asm("v_sub_f32_e32 %0, %1, %2":"=v"(r):"v"(a),"v"(b));return r;}
typedef float f32x2_t __attribute__((ext_vector_type(2))); typedef __bf16 bf16x2_t __attribute__((ext_vector_type(2)));
__device__ __forceinline__ unsigned cvtpk_s(float lo,float hi){f32x2_t v={lo,hi};bf16x2_t b=__builtin_convertvector(v,bf16x2_t);return __builtin_bit_cast(unsigned,b);}
#define WAIT_BAR(N) asm volatile("s_waitcnt vmcnt(" #N ") lgkmcnt(0)\n\ts_barrier":::"memory")

__device__ __forceinline__ void qkt(f32x16&p0,f32x16&p1,const char*Kslot,const bf16x8*qr,const f32x16&negm,int r32,int hi){
  const char*kb=Kslot+hi*1024+r32*16;
  #pragma unroll
  for(int d0=0;d0<4;++d0){
    const bf16x8 b0=*reinterpret_cast<const bf16x8*>(kb+d0*2048);
    const bf16x8 b1=*reinterpret_cast<const bf16x8*>(kb+d0*2048+512);
    if(d0==0){p0=__builtin_amdgcn_mfma_f32_32x32x16_bf16(b0,qr[0],negm,0,0,0);p1=__builtin_amdgcn_mfma_f32_32x32x16_bf16(b1,qr[0],negm,0,0,0);}
    else{p0=__builtin_amdgcn_mfma_f32_32x32x16_bf16(b0,qr[d0],p0,0,0,0);p1=__builtin_amdgcn_mfma_f32_32x32x16_bf16(b1,qr[d0],p1,0,0,0);}}
}
typedef __attribute__((address_space(3))) const char* lds_cptr;
typedef short v4i16_t __attribute__((ext_vector_type(4)));
__device__ __forceinline__ void kload8(bf16x8*kf,lds_cptr kp){
  kf[0]=*(const __attribute__((address_space(3))) bf16x8*)(kp);      kf[1]=*(const __attribute__((address_space(3))) bf16x8*)(kp+512);
  kf[2]=*(const __attribute__((address_space(3))) bf16x8*)(kp+2048); kf[3]=*(const __attribute__((address_space(3))) bf16x8*)(kp+2560);
  kf[4]=*(const __attribute__((address_space(3))) bf16x8*)(kp+4096); kf[5]=*(const __attribute__((address_space(3))) bf16x8*)(kp+4608);
  kf[6]=*(const __attribute__((address_space(3))) bf16x8*)(kp+6144); kf[7]=*(const __attribute__((address_space(3))) bf16x8*)(kp+6656);
}
__device__ __forceinline__ void kload2(bf16x8*kf,lds_cptr kp,int j){ kf[2*j]=*(const __attribute__((address_space(3))) bf16x8*)(kp+j*2048); kf[2*j+1]=*(const __attribute__((address_space(3))) bf16x8*)(kp+j*2048+512); }
__device__ __forceinline__ s16x4 vtr(lds_cptr p){ return __builtin_bit_cast(s16x4,__builtin_amdgcn_ds_read_tr16_b64_v4i16((__attribute__((address_space(3))) v4i16_t*)p)); }
__device__ __forceinline__ float rowmax(const f32x16&p0,const f32x16&p1){
  float a=max3f(p0[0],p0[1],p1[0]),b=max3f(p0[2],p0[3],p1[1]);a=max3f(a,p1[2],p1[3]);
  #pragma unroll
  for(int r=4;r<16;r+=4){a=max3f(a,p0[r],p0[r+1]);b=max3f(b,p0[r+2],p0[r+3]);a=max3f(a,p1[r],p1[r+1]);b=max3f(b,p1[r+2],p1[r+3]);}
  const float m=max2f(a,b);
  auto rr=__builtin_amdgcn_permlane32_swap(__float_as_uint(m),__float_as_uint(m),false,false);
  return max2f(__uint_as_float(rr[0]),__uint_as_float(rr[1]));
}
__device__ __forceinline__ void pv(f32x16*o,int vb,bf16x8 pa0,bf16x8 pa1,bf16x8 pa2,bf16x8 pa3){
  #pragma unroll
  for(int d0=0;d0<2;++d0){s16x4 lo[4],hi[4];
    #pragma unroll
    for(int ks=0;ks<4;++ks){
      asm volatile("ds_read_b64_tr_b16 %0,%1 offset:%c2":"=&v"(lo[ks]):"v"(vb),"i"(d0*4096+ks*1024):"memory");
      asm volatile("ds_read_b64_tr_b16 %0,%1 offset:%c2":"=&v"(hi[ks]):"v"(vb),"i"(d0*4096+ks*1024+512):"memory");}
    asm volatile("s_waitcnt lgkmcnt(0)":::"memory");SBAR();
    #define PK(k) (bf16x8){lo[k][0],lo[k][1],lo[k][2],lo[k][3],hi[k][0],hi[k][1],hi[k][2],hi[k][3]}
    o[d0]=__builtin_amdgcn_mfma_f32_32x32x16_bf16(pa0,PK(0),o[d0],0,0,0);
    o[d0]=__builtin_amdgcn_mfma_f32_32x32x16_bf16(pa1,PK(1),o[d0],0,0,0);
    o[d0]=__builtin_amdgcn_mfma_f32_32x32x16_bf16(pa2,PK(2),o[d0],0,0,0);
    o[d0]=__builtin_amdgcn_mfma_f32_32x32x16_bf16(pa3,PK(3),o[d0],0,0,0);
    #undef PK
  }
}

#ifndef ATTN_STORE16
#define ATTN_STORE16(p,v) (*(u32x4*)(p)=(v))
#endif
struct SpArgs { const unsigned short* el; int nvalid, nsel, h; long tok0; bf16* d0; bf16* d1; bf16* d2; float* lse; };
constexpr long LSE_STRIDE=32768L*16;
template<int MODE,int THRL> __device__ __forceinline__ void attn_unit(const bf16*Qu,const bf16*__restrict__ Ku,const bf16*__restrict__ Vu,bf16*Ou,const int NT,const unsigned*selp,const float sinkl2,char*shm,const SpArgs sp=SpArgs{},const unsigned entq_in=0u){
  constexpr int ld=(MODE==2||MODE==6)?1280:3072, ldo=(MODE==0||MODE==3)?2048:1024; constexpr bool DV2=(MODE==3);
  int tid_=threadIdx.x; asm volatile("":"+v"(tid_)); const int tid=tid_,lane=tid&63,r32=lane&31,hi=lane>>5; const int wid=__builtin_amdgcn_readfirstlane(tid>>6);
  const bf16*Qw=(MODE==6)?(Qu+(wid>>2)*64+(long)((wid&3)*QBLK)*ld):(Qu+(long)(wid*QBLK)*ld);
  const bf16*Kh=Ku,*Vh=Vu;
  const unsigned lds0=(unsigned)(uintptr_t)shm;
  float*wsf=(float*)(shm+LDS_WS)+wid*64;
  unsigned selm_=0u; if(MODE==1)selm_=selp[(wid*QBLK+r32)*16];
  #define SELM() selm_
  const unsigned koff=(unsigned)(lane*ld+wid*8)*2u;
  const unsigned voffv=(unsigned)((16*(wid&3)+(lane>>2))*ld+(wid>>2)*32+(lane&3)*8)*2u;
  const unsigned kdst=lds0+LDS_K+wid*1024, vdst=lds0+LDS_V+wid*1024;
  #define DMA_K(t,slot) glds16s(Kh+(long)(t)*KVBLK*ld,koff,(unsigned)__builtin_amdgcn_readfirstlane(kdst+(slot)))
  #define DMA_V(t,slot) do{ glds16s(Vh+(long)(t)*KVBLK*ld,voffv,(unsigned)__builtin_amdgcn_readfirstlane(vdst+(slot))); if(DV2)glds16s(Vh+64+(long)(t)*KVBLK*ld,voffv,(unsigned)__builtin_amdgcn_readfirstlane(vdst+V2OFF+(slot))); }while(0)
  #define WB(N2,N3) do{ if(DV2){WAIT_BAR(N3);}else{WAIT_BAR(N2);} }while(0)
  const int vb0=(int)(lds0+LDS_V)+((lane>>4)&1)*32+(lane&3)*8+(4*hi+((lane&15)>>2))*64;
  const char*Kbase=shm+LDS_K; bf16x8 kf[8];
  const lds_cptr shm3=(lds_cptr)shm; const lds_cptr kp0=shm3+LDS_K+hi*1024+r32*16; const lds_cptr vp0=shm3+LDS_V+((lane>>4)&1)*32+(lane&3)*8+(4*hi+((lane&15)>>2))*64;
  DMA_K(0,0);DMA_V(0,0);DMA_K(1,SLOTB);
  bf16x8 qr[4];
  const unsigned entq=(MODE==4)?entq_in:0u;
  const bf16*Qrow=(MODE==4)?(Qu+(long)(entq&0x1FFFu)*ld):(Qw+(long)r32*ld);
  #pragma unroll
  for(int d0=0;d0<4;++d0)qr[d0]=*reinterpret_cast<const bf16x8*>(&Qrow[d0*16+hi*8]);
  float mhat=0.f,l_reg=0.f;f32x16 o[DV2?4:2];o[0]=f32x16{};o[1]=f32x16{};if(DV2){o[DV2?2:0]=f32x16{};o[DV2?3:1]=f32x16{};}const f32x16 zero16=f32x16{};
  const int qrel=((MODE==6)?(wid&3):wid)*QBLK+r32;
  const bool act=(MODE!=4)||(wid*QBLK<sp.nvalid);
  #define CMASK(P0,P1,t) xmask<(MODE==6)?2:MODE>(P0,P1,(t),(MODE==6)?(sp.nsel+4):NT,qrel,hi,(MODE==1)?SELM():0u)
  bool resc=false;
  #define START(P0,P1) do{ const float rm=rowmax(P0,P1); resc=false; \
    { const float dl=(MODE==0||MODE==3||MODE==4||MODE==5)?rm:__builtin_fmaxf(rm,-64.f); mhat=fadd_s(mhat,dl); \
      _Pragma("unroll") for(int r=0;r<16;++r){P0[r]=fsub_s(P0[r],dl);P1[r]=fsub_s(P1[r],dl);} \
      } \
    _Pragma("unroll") for(int r=0;r<16;++r)P0[r]=__builtin_amdgcn_exp2f(P0[r]); }while(0)
  #define RESC() do{ if(resc){ asm volatile("s_waitcnt lgkmcnt(0)":::"memory"); \
      _Pragma("unroll") for(int d_=0;d_<(DV2?4:2);++d_) _Pragma("unroll") for(int r=0;r<16;++r)o[d_][r]*=wsf[crow(r,hi)]; } }while(0)
  f32x16 pA0,pA1,pB0,pB1;
  int sl_prev=0,sl_cur=0,sl_next=SLOTB;
  #define ROT() do{sl_prev=sl_cur;sl_cur=sl_next;sl_next=(sl_next==(NSLOT-1)*SLOTB)?0:sl_next+SLOTB;}while(0)
  DMA_K(2,2*SLOTB);
  WB(3,4);
  if(act){
  qkt(pA0,pA1,Kbase,qr,zero16,r32,hi);asm volatile("s_nop 15\n\ts_nop 7":"+v"(pA0),"+v"(pA1));CMASK(pA0,pA1,0);
  START(pA0,pA1);
  _Pragma("unroll") for(int r=0;r<16;++r)pA1[r]=__builtin_amdgcn_exp2f(pA1[r]);
  }
  WAIT_BAR(0);
  DMA_K(3,0);DMA_V(1,SLOTB);
  ROT();
  if(act)kload8(kf,kp0+sl_cur);
  WB(2,3);
  s16x4 vlo[8],vhi[8]; u32x4 pw0,pw1,pw2,pw3;
  #define PKW(P,B) cvtpk_s(P[B],P[B+1])
  #define PAF(k) __builtin_bit_cast(bf16x8,pw##k)
  #define VFR(i) (bf16x8){vlo[i][0],vlo[i][1],vlo[i][2],vlo[i][3],vhi[i][0],vhi[i][1],vhi[i][2],vhi[i][3]}
  #define PIN(x) asm volatile("":"+v"(x))
  #define MX3(a,b,c) __builtin_fmaxf(__builtin_fmaxf((a),(b)),(c))
  #define GAPA(MF,A0,A1,A2,A3,W0,W1,PW) do{ MF; sacc+=A0; sacc+=A1; sacc+=A2; sacc+=A3; PIN(sacc); W0; W1; PIN(PW); SBAR(); }while(0)
  #define EX(v) __builtin_amdgcn_exp2f(v)
  #define GAPB(MF,X,B) do{ MF; X[B]=EX(X[B]); X[B+1]=EX(X[B+1]); X[B+2]=EX(X[B+2]); X[B+3]=EX(X[B+3]); PIN(X); SBAR(); }while(0)
  #define VRD(i) do{ vlo[i]=vtr(vp_+(((i)>>2)*4096+((i)&3)*1024)); vhi[i]=vtr(vp_+(((i)>>2)*4096+((i)&3)*1024+512)); }while(0)
  #define KRD(G,j) do{ if(G){ kload2(kf,kp0+sl_next,j); SBAR(); } }while(0)
  #define STEP(C0,C1,P0,P1,t,GK,GV,GL) do{ SBAR(); \
    const lds_cptr vp_=vp0+sl_prev; \
    VRD(0); SBAR(); float sacc=(P0[0]+P0[1]); \
    GAPA(C0=__builtin_amdgcn_mfma_f32_32x32x16_bf16(kf[0],qr[0],zero16,0,0,0), P0[2],P0[3],P0[4],P0[5],     pw0[0]=PKW(P0,0), pw0[1]=PKW(P0,2), pw0); \
    VRD(4); SBAR(); GAPA(C1=__builtin_amdgcn_mfma_f32_32x32x16_bf16(kf[1],qr[0],zero16,0,0,0), P0[6],P0[7],P0[8],P0[9],     pw0[2]=PKW(P0,4), pw0[3]=PKW(P0,6), pw0); \
    VRD(1); SBAR(); GAPA(C0=__builtin_amdgcn_mfma_f32_32x32x16_bf16(kf[2],qr[1],C0,0,0,0),   P0[10],P0[11],P0[12],P0[13], pw1[0]=PKW(P0,8), pw1[1]=PKW(P0,10), pw1); \
    VRD(5); SBAR(); GAPA(C1=__builtin_amdgcn_mfma_f32_32x32x16_bf16(kf[3],qr[1],C1,0,0,0),   P0[14],P0[15],P1[0],P1[1],   pw1[2]=PKW(P0,12),pw1[3]=PKW(P0,14), pw1); \
    VRD(2); SBAR(); GAPA(C0=__builtin_amdgcn_mfma_f32_32x32x16_bf16(kf[4],qr[2],C0,0,0,0),   P1[2],P1[3],P1[4],P1[5],     pw2[0]=PKW(P1,0), pw2[1]=PKW(P1,2), pw2); \
    VRD(6); SBAR(); GAPA(C1=__builtin_amdgcn_mfma_f32_32x32x16_bf16(kf[5],qr[2],C1,0,0,0),   P1[6],P1[7],P1[8],P1[9],     pw2[2]=PKW(P1,4), pw2[3]=PKW(P1,6), pw2); \
    VRD(3); SBAR(); GAPA(C0=__builtin_amdgcn_mfma_f32_32x32x16_bf16(kf[6],qr[3],C0,0,0,0),   P1[10],P1[11],P1[12],P1[13], pw3[0]=PKW(P1,8), pw3[1]=PKW(P1,10), pw3); \
    VRD(7); SBAR(); GAPA(C1=__builtin_amdgcn_mfma_f32_32x32x16_bf16(kf[7],qr[3],C1,0,0,0),   P1[14],P1[15],0.f,0.f,       pw3[2]=PKW(P1,12),pw3[3]=PKW(P1,14), pw3); \
    l_reg+=sacc; \
    if(GK){DMA_K((t)+3,sl_cur);} if(GV){DMA_V((t)+1,sl_next);} \
    { float msub_=mhat; if(MODE==1){ if((t)<NT-4 && !((SELM()>>((t)>>2))&1u)) msub_=INFINITY; }     \
      _Pragma("unroll") for(int r=0;r<16;++r){C0[r]-=msub_;C1[r]-=msub_;} } \
    CMASK(C0,C1,t); \
    { float a=MX3(C0[0],C0[1],C1[0]),b=MX3(C0[2],C0[3],C1[1]); a=MX3(a,C1[2],C1[3]); \
      _Pragma("unroll") for(int r=4;r<16;r+=4){a=MX3(a,C0[r],C0[r+1]);b=MX3(b,C0[r+2],C0[r+3]);a=MX3(a,C1[r],C1[r+1]);b=MX3(b,C1[r+2],C1[r+3]);} \
      float rm=__builtin_fmaxf(a,b); { auto rr=__builtin_amdgcn_permlane32_swap(__float_as_uint(rm),__float_as_uint(rm),false,false); rm=__builtin_fmaxf(__uint_as_float(rr[0]),__uint_as_float(rr[1])); } \
      resc=false; \
      if(__builtin_expect(__any(rm>(float)THRL),0)){ const float dl=__builtin_fmaxf(rm,0.f); mhat+=dl; \
        _Pragma("unroll") for(int r=0;r<16;++r){C0[r]-=dl;C1[r]-=dl;} \
        const float f=__builtin_amdgcn_exp2f(-dl); l_reg*=f; if(hi==0)wsf[r32]=f; resc=true; } } \
    SBAR(); __builtin_amdgcn_s_setprio(1); \
    GAPB(o[0]=__builtin_amdgcn_mfma_f32_32x32x16_bf16(PAF(0),VFR(0),o[0],0,0,0), C0,0); \
    GAPB(o[1]=__builtin_amdgcn_mfma_f32_32x32x16_bf16(PAF(0),VFR(4),o[1],0,0,0), C0,4); \
    KRD(GL,0); GAPB(o[0]=__builtin_amdgcn_mfma_f32_32x32x16_bf16(PAF(1),VFR(1),o[0],0,0,0), C0,8); \
    KRD(GL,1); GAPB(o[1]=__builtin_amdgcn_mfma_f32_32x32x16_bf16(PAF(1),VFR(5),o[1],0,0,0), C0,12); \
    KRD(GL,2); GAPB(o[0]=__builtin_amdgcn_mfma_f32_32x32x16_bf16(PAF(2),VFR(2),o[0],0,0,0), C1,0); \
    KRD(GL,3); GAPB(o[1]=__builtin_amdgcn_mfma_f32_32x32x16_bf16(PAF(2),VFR(6),o[1],0,0,0), C1,4); \
    GAPB(o[0]=__builtin_amdgcn_mfma_f32_32x32x16_bf16(PAF(3),VFR(3),o[0],0,0,0), C1,8); \
    GAPB(o[1]=__builtin_amdgcn_mfma_f32_32x32x16_bf16(PAF(3),VFR(7),o[1],0,0,0), C1,12); \
    __builtin_amdgcn_s_setprio(0); \
    }while(0)
  #define PV2() do{ if(DV2){ SBAR(); pv(o+(DV2?2:0),vb0+V2OFF+sl_prev,PAF(0),PAF(1),PAF(2),PAF(3)); SBAR(); } }while(0)
  int t=1;
  #undef CMASK
  #define CMASK(P0,P1,t) do{}while(0)
  for(;t+5<NT;t+=2){
    STEP(pB0,pB1,pA0,pA1,t,true,true,true);     PV2(); WB(2,3); RESC(); ROT();
    STEP(pA0,pA1,pB0,pB1,t+1,true,true,true);   PV2(); WB(2,3); RESC(); ROT();
  }
  #undef CMASK
  #define CMASK(P0,P1,t) xmask<(MODE==6)?2:MODE>(P0,P1,(t),(MODE==6)?(sp.nsel+4):NT,qrel,hi,(MODE==1)?SELM():0u)
  #define XSTEP(C0,C1,P0,P1,t,GK,GV,GL) do{ if(act){ STEP(C0,C1,P0,P1,t,GK,GV,GL); } else { if(GK){DMA_K((t)+3,sl_cur);} if(GV){DMA_V((t)+1,sl_next);} } }while(0)
  #define ENDW(tt) do{ if((tt)+3<NT){WB(2,3);} else if((tt)+2<NT){WB(1,2);} else {WAIT_BAR(0);} }while(0)
  for(;t+1<NT;t+=2){
    XSTEP(pB0,pB1,pA0,pA1,t,(t+3<NT),(t+1<NT),(t+1<NT));      PV2(); ENDW(t);   RESC(); ROT();
    XSTEP(pA0,pA1,pB0,pB1,t+1,(t+4<NT),(t+2<NT),(t+2<NT));    PV2(); ENDW(t+1); RESC(); ROT();
  }
  XSTEP(pB0,pB1,pA0,pA1,NT-1,false,false,false); PV2(); RESC();
  if(act){ float sacc=pB0[0]+pB0[1]; _Pragma("unroll") for(int r=2;r<16;++r)sacc+=pB0[r]; _Pragma("unroll") for(int r=0;r<16;++r)sacc+=pB1[r]; l_reg+=sacc;
    pw0=(u32x4){PKW(pB0,0),PKW(pB0,2),PKW(pB0,4),PKW(pB0,6)};pw1=(u32x4){PKW(pB0,8),PKW(pB0,10),PKW(pB0,12),PKW(pB0,14)};pw2=(u32x4){PKW(pB1,0),PKW(pB1,2),PKW(pB1,4),PKW(pB1,6)};pw3=(u32x4){PKW(pB1,8),PKW(pB1,10),PKW(pB1,12),PKW(pB1,14)};
    SBAR(); pv(o,vb0+sl_cur,PAF(0),PAF(1),PAF(2),PAF(3)); if(DV2)pv(o+(DV2?2:0),vb0+V2OFF+sl_cur,PAF(0),PAF(1),PAF(2),PAF(3)); }
  #undef PV2
  #undef PKW
  #undef PAF
  #undef VFR
  #undef PIN
  #undef MX3
  #undef GAPA
  #undef GAPB
  #undef EX
  #undef VRD
  #undef KRD
  #undef STEP
  #undef ENDW
  #undef XSTEP
  {auto rr=__builtin_amdgcn_permlane32_swap(__float_as_uint(l_reg),__float_as_uint(l_reg),false,false);l_reg=__uint_as_float(rr[0])+__uint_as_float(rr[1]);}
  if(MODE==2)l_reg+=__builtin_amdgcn_exp2f(sinkl2-mhat);
  if(MODE==6)l_reg+=__builtin_amdgcn_exp2f(((const float*)selp)[wid>>2]*(C2*8.0f)-mhat);
  if(MODE==4){ if(hi==0&&wid*QBLK+r32<sp.nvalid)sp.lse[(long)(entq>>13)*LSE_STRIDE+(sp.tok0+(long)(entq&0x1FFFu))*16+sp.h]=mhat+__builtin_amdgcn_logf(l_reg); }
  const float lse_own=mhat+__builtin_amdgcn_logf(l_reg);
  if(hi==0)wsf[32+r32]=l_reg;asm volatile("s_waitcnt lgkmcnt(0)":::"memory");
  float rli[16];
  #pragma unroll
  for(int r=0;r<16;++r)rli[r]=__builtin_amdgcn_rcpf(wsf[32+crow(r,hi)]);
  bf16*Ow=(MODE==6)?(Ou+(wid>>2)*64+(long)((wid&3)*QBLK)*ldo):(Ou+(long)(wid*QBLK)*ldo);
  { bf16*stg=(bf16*)(shm+LDS_OST)+wid*2048;
    #pragma unroll
    for(int r=0;r<16;++r){const int orow=crow(r,hi);
      #pragma unroll
      for(int d0=0;d0<2;++d0)stg[orow*64+d0*32+r32]=__float2bfloat16(o[d0][r]*rli[r]);}
    asm volatile("s_waitcnt lgkmcnt(0)":::"memory");
    if(MODE==4){
      unsigned e4_[4];
      #pragma unroll
      for(int i=0;i<4;++i){const int ri_=wid*QBLK+i*8+(lane>>3); const unsigned ev_=(unsigned)__builtin_amdgcn_ds_bpermute((i*8+(lane>>3))<<2,(int)entq); e4_[i]=(ri_<sp.nvalid)?ev_:0xFFFFFFFFu;}
      #pragma unroll
      for(int i=0;i<4;++i){const int row=i*8+(lane>>3),ch=lane&7;
        if(e4_[i]!=0xFFFFFFFFu){ const unsigned e_=e4_[i]; const long tk_=sp.tok0+(long)(e_&0x1FFFu); const unsigned sl_=e_>>13;
          bf16*dst_=(sl_==0u)?(sp.d0+tk_*1024+sp.h*64):(((sl_==1u)?sp.d1:sp.d2)+(tk_*16+sp.h)*64);
          const u32x4 v=*(const u32x4*)(stg+row*64+ch*8); ATTN_STORE16(dst_+ch*8,v); } }
    } else if(MODE==5){
      if(hi==0)wsf[32+r32]=lse_own; asm volatile("s_waitcnt lgkmcnt(0)":::"memory");
      float ls4_[4][3]; u32x4 pv4_[4][3];
      #pragma unroll
      for(int i=0;i<4;++i){const int row=i*8+(lane>>3),ch=lane&7; const long tk_=sp.tok0+wid*QBLK+row;
        #pragma unroll
        for(int s_=0;s_<3;++s_){ ls4_[i][s_]=-INFINITY; pv4_[i][s_]=(u32x4){0u,0u,0u,0u};
          if(s_<sp.nsel){ ls4_[i][s_]=sp.lse[(long)s_*LSE_STRIDE+tk_*16+sp.h];
            const bf16*src_=(s_==0)?(sp.d0+tk_*1024+sp.h*64):(((s_==1)?sp.d1:sp.d2)+(tk_*16+sp.h)*64); pv4_[i][s_]=*(const u32x4*)(src_+ch*8); } } }
      #pragma unroll
      for(int i=0;i<4;++i){const int row=i*8+(lane>>3),ch=lane&7; const long tk_=sp.tok0+wid*QBLK+row; const float lo_=wsf[32+row];
        const u32x4 v=*(const u32x4*)(stg+row*64+ch*8);
        float m_=lo_;
        #pragma unroll
        for(int s_=0;s_<3;++s_)m_=__builtin_fmaxf(m_,ls4_[i][s_]);
        float w_=__builtin_amdgcn_exp2f(lo_-m_),den_=w_; float a_[8];
        #pragma unroll
        for(int e=0;e<4;++e){ a_[2*e]=w_*__uint_as_float(v[e]<<16); a_[2*e+1]=w_*__uint_as_float(v[e]&0xffff0000u); }
        #pragma unroll
        for(int s_=0;s_<3;++s_){ const float ws_=__builtin_amdgcn_exp2f(ls4_[i][s_]-m_); den_+=ws_;
            #pragma unroll
            for(int e=0;e<4;++e){ a_[2*e]+=ws_*__uint_as_float(pv4_[i][s_][e]<<16); a_[2*e+1]+=ws_*__uint_as_float(pv4_[i][s_][e]&0xffff0000u); } }
        const float inv_=__builtin_amdgcn_rcpf(den_);
        u32x4 o_; o_[0]=cvtpk_s(a_[0]*inv_,a_[1]*inv_); o_[1]=cvtpk_s(a_[2]*inv_,a_[3]*inv_); o_[2]=cvtpk_s(a_[4]*inv_,a_[5]*inv_); o_[3]=cvtpk_s(a_[6]*inv_,a_[7]*inv_);
        ATTN_STORE16(sp.d0+tk_*1024+sp.h*64+ch*8,o_); }
    } else {
    #pragma unroll
    for(int i=0;i<4;++i){const int row=i*8+(lane>>3),ch=lane&7; const u32x4 v=*(const u32x4*)(stg+row*64+ch*8); ATTN_STORE16(Ow+(long)row*ldo+ch*8,v);}
    }
    if(DV2){ asm volatile("s_waitcnt lgkmcnt(0)":::"memory");
      #pragma unroll
      for(int r=0;r<16;++r){const int orow=crow(r,hi);
        #pragma unroll
        for(int d0=0;d0<2;++d0)stg[orow*64+d0*32+r32]=__float2bfloat16(o[DV2?2+d0:d0][r]*rli[r]);}
      asm volatile("s_waitcnt lgkmcnt(0)":::"memory");
      #pragma unroll
      for(int i=0;i<4;++i){const int row=i*8+(lane>>3),ch=lane&7; const u32x4 v=*(const u32x4*)(stg+row*64+ch*8); ATTN_STORE16(Ow+(long)row*ldo+64+ch*8,v);} } }
  asm volatile("s_waitcnt lgkmcnt(0)\n\ts_barrier":::"memory");
  #undef SELM
  #undef DMA_K
  #undef DMA_V
  #undef WB
  #undef CMASK
  #undef START
  #undef RESC
  #undef ROT
}
constexpr int ATTN_LDS_BYTES=LDS_BYTES;
#undef SBAR
#undef WAIT_BAR
}
#define GAS __attribute__((address_space(1)))
#define LAS __attribute__((address_space(3)))
typedef unsigned short bf16;
typedef unsigned v4u __attribute__((ext_vector_type(4)));
typedef unsigned v2u __attribute__((ext_vector_type(2)));
typedef float f32x4 __attribute__((ext_vector_type(4)));
typedef short bf16x8 __attribute__((ext_vector_type(8)));
#define LDS_WAIT() asm volatile("s_waitcnt lgkmcnt(0)" ::: "memory")

constexpr int NB = 4, SEQ = 8192, T = NB * SEQ, DM = 1024, DFF = 4096, DEPTH = 4, NH = 16;
constexpr float EPS = 1e-6f;
constexpr float LOG2E = 1.4426950408889634f;
constexpr size_t MiB = 1u << 20;
constexpr size_t WS_W = 0, W_LAYER = 24 * MiB, W_IN = 0, W_OUT = 6 * MiB, W_UP = 8 * MiB, W_DOWN = 16 * MiB;
constexpr size_t WS_ROPE = 96 * MiB, WS_SEL = 98 * MiB, WS_KM = 100 * MiB, WS_XN = 102 * MiB, WS_QKV = 166 * MiB, WS_O2 = 358 * MiB, WS_U = 166 * MiB, WS_HB = 422 * MiB, WS_RSQ = 486 * MiB, WS_CTL = 488 * MiB, WS_LSE = 489 * MiB, WS_END = 495 * MiB;
constexpr size_t WS_CNT = WS_CTL + 65536;
constexpr size_t WS_LIST = WS_W;
constexpr size_t WS_P1 = WS_O2, WS_P2 = WS_O2 + 64 * MiB;
constexpr int LDS_PRE = 98304, LDS_TMP = 110592;
constexpr int LDS_BYTES = 147456, LDSCTL_OFF = 131072;
constexpr int NWAVES = 8;

__device__ __forceinline__ float bf2f(unsigned short b) { return __uint_as_float((unsigned)b << 16); }
__device__ __forceinline__ float shx(float v, int k, int lane) { return __int_as_float(__builtin_amdgcn_ds_bpermute((lane ^ k) << 2, __float_as_int(v))); }
__device__ __forceinline__ float wave_sum(float v, int lane) {
#pragma unroll
    for (int o = 1; o < 64; o <<= 1) v += shx(v, o, lane);
    return v;
}
__device__ __forceinline__ void transpose_item(const float* W, const float* gk, int K, int N, bf16* WT, LAS float* scr, int item, int lane) {
    const int nblk = N / 32, kb = item / nblk, nb = item % nblk, k0 = 64 * kb, n0 = 32 * nb;
#pragma unroll 8
    for (int i = 0; i < 32; ++i) { const int kk = 2 * i + (lane >> 5); scr[kk * 33 + (lane & 31)] = W[(size_t)(k0 + kk) * N + n0 + (lane & 31)] * (gk ? gk[k0 + kk] : 1.f); }
    LDS_WAIT(); asm volatile("" ::: "memory");
    const int c = lane & 7;
#pragma unroll
    for (int j = 0; j < 4; ++j) { const int n = (lane >> 3) + 8 * j; const LAS float* s = scr + (8 * c) * 33 + n;
        v4u o; o.x = pg8::cvt_pk_bf16(s[0 * 33], s[1 * 33]); o.y = pg8::cvt_pk_bf16(s[2 * 33], s[3 * 33]); o.z = pg8::cvt_pk_bf16(s[4 * 33], s[5 * 33]); o.w = pg8::cvt_pk_bf16(s[6 * 33], s[7 * 33]);
        *(v4u*)(WT + (size_t)(n0 + n) * K + k0 + 8 * c) = o; }
    LDS_WAIT(); asm volatile("" ::: "memory");
}
__device__ __forceinline__ void rms_row_to_bf16(const float* xrow, const float* g, bf16* orow, int lane) {
    const f32x4* xr = (const f32x4*)xrow + lane; const f32x4* gr = (const f32x4*)g + lane;
    f32x4 v[4]; float s = 0.f;
#pragma unroll
    for (int j = 0; j < 4; ++j) { v[j] = xr[64 * j]; s += (v[j].x * v[j].x + v[j].y * v[j].y) + (v[j].z * v[j].z + v[j].w * v[j].w); }
    const float r = 1.0f / sqrtf(wave_sum(s, lane) * (1.f / DM) + EPS);
    v2u* o8 = (v2u*)orow + lane;
#pragma unroll
    for (int j = 0; j < 4; ++j) { const f32x4 gg = gr[64 * j]; v2u w; w.x = pg8::cvt_pk_bf16(v[j].x * r * gg.x, v[j].y * r * gg.y); w.y = pg8::cvt_pk_bf16(v[j].z * r * gg.z, v[j].w * r * gg.w); o8[64 * j] = w; }
}
__device__ __forceinline__ void row_to_bf16_sumsq(const float* xrow, bf16* orow, float* rsq, int lane) {
    const f32x4* xr = (const f32x4*)xrow + lane;
    f32x4 v[4]; float s = 0.f;
#pragma unroll
    for (int j = 0; j < 4; ++j) { v[j] = xr[64 * j]; s += (v[j].x * v[j].x + v[j].y * v[j].y) + (v[j].z * v[j].z + v[j].w * v[j].w); }
    s = wave_sum(s, lane);
    v2u* o8 = (v2u*)orow + lane;
#pragma unroll
    for (int j = 0; j < 4; ++j) { v2u w; w.x = pg8::cvt_pk_bf16(v[j].x, v[j].y); w.y = pg8::cvt_pk_bf16(v[j].z, v[j].w); o8[64 * j] = w; }
    if (lane < 16) rsq[lane] = (lane == 0) ? s : 0.f;
}
__device__ __forceinline__ void rms_rowb_to_f32(const bf16* xrow, const float* g, float* orow, int lane) {
    const v2u* xr = (const v2u*)xrow + lane; const f32x4* gr = (const f32x4*)g + lane;
    f32x4 v[4]; float s = 0.f;
#pragma unroll
    for (int j = 0; j < 4; ++j) { const v2u q = xr[64 * j]; v[j] = (f32x4){__uint_as_float(q.x << 16), __uint_as_float(q.x & 0xffff0000u), __uint_as_float(q.y << 16), __uint_as_float(q.y & 0xffff0000u)};
        s += (v[j].x * v[j].x + v[j].y * v[j].y) + (v[j].z * v[j].z + v[j].w * v[j].w); }
    const float r = 1.0f / sqrtf(wave_sum(s, lane) * (1.f / DM) + EPS);
    f32x4* o = (f32x4*)orow + lane;
#pragma unroll
    for (int j = 0; j < 4; ++j) { const f32x4 gg = gr[64 * j]; o[64 * j] = (v[j] * r) * gg; }
}
__device__ __forceinline__ void rms_rowb2_to_f32(const bf16* xa, const bf16* xb, const float* g, float* oa, float* ob, int lane) {
    const v2u* xr[2] = {(const v2u*)xa + lane, (const v2u*)xb + lane}; const f32x4* gr = (const f32x4*)g + lane;
    v2u q[2][4];
#pragma unroll
    for (int r = 0; r < 2; ++r)
#pragma unroll
        for (int j = 0; j < 4; ++j) q[r][j] = xr[r][64 * j];
    f32x4 gg[4];
#pragma unroll
    for (int j = 0; j < 4; ++j) gg[j] = gr[64 * j];
#pragma unroll
    for (int r = 0; r < 2; ++r) { f32x4 v[4]; float s = 0.f;
#pragma unroll
        for (int j = 0; j < 4; ++j) { v[j] = (f32x4){__uint_as_float(q[r][j].x << 16), __uint_as_float(q[r][j].x & 0xffff0000u), __uint_as_float(q[r][j].y << 16), __uint_as_float(q[r][j].y & 0xffff0000u)};
            s += (v[j].x * v[j].x + v[j].y * v[j].y) + (v[j].z * v[j].z + v[j].w * v[j].w); }
        const float rr = 1.0f / sqrtf(wave_sum(s, lane) * (1.f / DM) + EPS);
        f32x4* o = (f32x4*)(r ? ob : oa) + lane;
#pragma unroll
        for (int j = 0; j < 4; ++j) o[64 * j] = (v[j] * rr) * gg[j]; }
}
__device__ __forceinline__ void rms_row_to_f32(const float* xrow, const float* g, float* orow, int lane) {
    const f32x4* xr = (const f32x4*)xrow + lane; const f32x4* gr = (const f32x4*)g + lane;
    f32x4 v[4]; float s = 0.f;
#pragma unroll
    for (int j = 0; j < 4; ++j) { v[j] = xr[64 * j]; s += (v[j].x * v[j].x + v[j].y * v[j].y) + (v[j].z * v[j].z + v[j].w * v[j].w); }
    const float r = 1.0f / sqrtf(wave_sum(s, lane) * (1.f / DM) + EPS);
    f32x4* o = (f32x4*)orow + lane;
#pragma unroll
    for (int j = 0; j < 4; ++j) { const f32x4 gg = gr[64 * j]; o[64 * j] = (v[j] * r) * gg; }
}

#define XB_TMO      128
#define XB_XCNT(j)  (256  + 64 * (j))
#define XB_XSUB(j)  (1280 + 64 * (j))
#define XB_XGEN(j)  (2304 + 64 * (j))
#define XB_TOP      3328
#define XB_TOPGEN   3392
#define XCD_BAR_WORDS 3456
#define XB_SPIN_CAP (1u << 18)

__device__ __forceinline__ unsigned xb_ld(unsigned* p)              { return __hip_atomic_load(p, __ATOMIC_RELAXED, __HIP_MEMORY_SCOPE_AGENT); }
__device__ __forceinline__ unsigned xb_add(unsigned* p, unsigned v) { return __hip_atomic_fetch_add(p, v, __ATOMIC_RELAXED, __HIP_MEMORY_SCOPE_AGENT); }
__device__ __forceinline__ unsigned xb_xcc_id() { return (unsigned)__builtin_amdgcn_s_getreg((3 << 11) | 20) & 0xFu; }
#define XB_SPIN(cond, bar) do { unsigned _sp = 0; while (cond) { __builtin_amdgcn_s_sleep(1); \
    if ((++_sp & 255u) == 0u) { if (xb_ld(&(bar)[XB_TMO])) break; if (_sp > XB_SPIN_CAP) { atomicAdd(&(bar)[XB_TMO], 1u); break; } } } } while (0)

struct XcdBarrier {
    unsigned* bar; unsigned x;
    volatile LAS unsigned* st;
};

__device__ __forceinline__ XcdBarrier xcd_barrier_post(unsigned* bar, volatile LAS unsigned* st) {
    XcdBarrier b; b.bar = bar; b.x = xb_xcc_id(); b.st = st;
    if (threadIdx.x == 0) (void)xb_add(&bar[XB_XCNT(b.x)], 1u);
    return b;
}
__device__ __forceinline__ void xcd_barrier_complete(unsigned* bar, unsigned x, unsigned& nloc, unsigned& nx) {
    const unsigned G = gridDim.x * gridDim.y * gridDim.z;
    unsigned sum, cnt, mine, sp = 0u;
    for (;;) {
        sum = 0u; cnt = 0u; mine = 0u;
#pragma unroll
        for (unsigned j = 0; j < 16; ++j) { const unsigned c = xb_ld(&bar[XB_XCNT(j)]); sum += c; cnt += (c > 0u) ? 1u : 0u; mine = (j == x) ? c : mine; }
        if (sum == G) break;
        __builtin_amdgcn_s_sleep(1);
        if ((++sp & 255u) == 0u) { if (xb_ld(&bar[XB_TMO])) break; if (sp > XB_SPIN_CAP) { atomicAdd(&bar[XB_TMO], 1u); break; } }
    }
    nloc = mine > 0u ? mine : 1u; nx = cnt > 0u ? cnt : 1u;
}

__device__ __forceinline__ void xcd_barrier(const XcdBarrier& b) {
    asm volatile("s_waitcnt vmcnt(0)" ::: "memory");
    __syncthreads();
    if (threadIdx.x == 0) {
        unsigned* bar = b.bar;
        __builtin_amdgcn_s_waitcnt(0);
        unsigned nloc = b.st[0], nx = b.st[1];
        if (nloc == 0u) { xcd_barrier_complete(bar, b.x, nloc, nx); b.st[0] = nloc; b.st[1] = nx; }
        const unsigned old = xb_add(&bar[XB_XSUB(b.x)], 1u);
        const unsigned gen = old / nloc;
        if (old + 1u == (gen + 1u) * nloc) {
            __builtin_amdgcn_fence(__ATOMIC_RELEASE, "agent");
            asm volatile("s_waitcnt vmcnt(0)" ::: "memory");
            const unsigned og = xb_add(&bar[XB_TOP], 1u);
            const unsigned tg = og / nx;
            if (og + 1u == (tg + 1u) * nx) xb_add(&bar[XB_TOPGEN], 1u);
            else XB_SPIN(xb_ld(&bar[XB_TOPGEN]) == tg, bar);
            __builtin_amdgcn_fence(__ATOMIC_ACQUIRE, "agent");
            xb_add(&bar[XB_XGEN(b.x)], 1u);
            asm volatile("s_waitcnt vmcnt(0)" ::: "memory");
        } else {
            XB_SPIN(xb_ld(&bar[XB_XGEN(b.x)]) == gen, bar);
            __builtin_amdgcn_fence(__ATOMIC_ACQUIRE, "agent");
            asm volatile("s_waitcnt vmcnt(0)" ::: "memory");
        }
    }
    __syncthreads();
}

struct Args { const float* in[20]; float* out; unsigned char* ws; };
typedef const Args __attribute__((address_space(4)))* KArgs;
__device__ __forceinline__ KArgs fresh_args() { KArgs p = (KArgs)__builtin_amdgcn_kernarg_segment_ptr(); asm volatile("" : "+s"(p)); return p; }

template <int L> __device__ __forceinline__ void layer_fwd(unsigned char* lds, const XcdBarrier& bar) {
#define ARGS_IN(k) (fresh_args()->in[k])
    int wave; { int t_ = threadIdx.x; asm volatile("" : "+v"(t_)); wave = __builtin_amdgcn_readfirstlane(t_ >> 6); }
#define FRESH_LANE() int lane; { int t_ = threadIdx.x; asm volatile("" : "+v"(t_)); lane = t_ & 63; }
    const int G = gridDim.x, bx = blockIdx.x;
    const int vcu = (G % 8 == 0) ? (bx % 8) * (G / 8) + bx / 8 : bx;
    const int gw = vcu * NWAVES + wave, NGW = G * NWAVES;
#define ws (fresh_args()->ws)
#define XIN (fresh_args()->in[0])
#define hbuf (fresh_args()->out)
#define ROPE ((float*)(ws + WS_ROPE))
#define SEL ((unsigned*)(ws + WS_SEL))
#define KM ((float*)(ws + WS_KM))
#define XN ((bf16*)(ws + WS_XN))
#define QKV ((bf16*)(ws + WS_QKV))
#define O2 ((bf16*)hbuf)
#define U ((bf16*)(ws + WS_U))
#define HB ((bf16*)(ws + WS_HB))
#define RSQ ((float*)(ws + WS_RSQ))
#define Win ((const bf16*)(ws + WS_W + (size_t)L * W_LAYER + W_IN))
#define Wout ((const bf16*)(ws + WS_W + (size_t)L * W_LAYER + W_OUT))
#define Wup ((const bf16*)(ws + WS_W + (size_t)L * W_LAYER + W_UP))
#define Wdown ((const bf16*)(ws + WS_W + (size_t)L * W_LAYER + W_DOWN))
    LAS unsigned char* ldsl = (LAS unsigned char*)lds;
    {
        constexpr int mixer = L % 3;
        constexpr int NQ = (mixer == 2) ? 1280 : 3072;
        {
            pg8::Gemm g{HB, Win, T, NQ, DM}; pg8::StaticOrder S; S.init(T, NQ, G, bx);
            pg8::EpiQKV E{QKV, NQ, (mixer == 2) ? ARGS_IN(14) : nullptr, ROPE, (mixer == 2) ? 1152 : 2048, 1024, attn_body::C2, RSQ};
            pg8::gemm_phase<pg8::EpiQKV, pg8::StaticOrder, true, true>(ldsl, g, S, E);
        }
        xcd_barrier(bar);
        if constexpr (mixer == 0) {
            for (int i = 0; i < 8; ++i) {
                int bh, qb;
                if (G == 256) { const int s = vcu & 7, k = i & 3; bh = (i >> 2) * 32 + (vcu >> 3); qb = (k == 0) ? s : (k == 1) ? 15 - s : (k == 2) ? 16 + s : 31 - s; }
                else break;
                const int b = bh >> 4, j = bh & 15;
                const size_t r0 = (size_t)b * SEQ, q0 = (size_t)qb * 256;
#ifndef NO_A0
                attn_body::attn_unit<3, 8>((const attn_body::bf16*)(QKV + (r0 + q0) * 3072 + j * 64), (const attn_body::bf16*)(QKV + r0 * 3072 + 1024 + j * 64),
                    (const attn_body::bf16*)(QKV + r0 * 3072 + 2048 + (j >> 1) * 128), (attn_body::bf16*)(O2 + (r0 + q0) * 2048 + j * 128), 4 * qb + 4, nullptr, 0.f, (char*)lds);
#endif
            }
            xcd_barrier(bar);
#ifndef NO_CMB
            {
                const int slot = L / 3;
                FRESH_LANE();
                const float lambda_init = 0.8f - 0.6f * expf(-0.3f * (float)L);
                const float s1 = wave_sum(ARGS_IN(6)[slot * 64 + lane] * ARGS_IN(7)[slot * 64 + lane], lane);
                const float s2 = wave_sum(ARGS_IN(8)[slot * 64 + lane] * ARGS_IN(9)[slot * 64 + lane], lane);
                const float lam = expf(s1) - expf(s2) + lambda_init;
                const int hh = lane >> 3, c = lane & 7;
                const float* sg = ARGS_IN(10) + slot * 128 + c * 16;
                float gsc[16];
#pragma unroll
                for (int e = 0; e < 16; ++e) gsc[e] = sg[e] * (1.f - lambda_init);
                for (int m = gw; m < T; m += NGW) {
                    const bf16* o0 = O2 + (size_t)m * 2048 + (2 * hh) * 128 + c * 16; const bf16* o1 = o0 + 128;
                    const bf16x8 a0 = *(const bf16x8*)o0, a1 = *(const bf16x8*)(o0 + 8), b0 = *(const bf16x8*)o1, b1 = *(const bf16x8*)(o1 + 8);
                    float v[16]; float ss = 0.f;
#pragma unroll
                    for (int e = 0; e < 8; ++e) { v[e] = bf2f((unsigned short)a0[e]) - lam * bf2f((unsigned short)b0[e]); v[8 + e] = bf2f((unsigned short)a1[e]) - lam * bf2f((unsigned short)b1[e]); }
#pragma unroll
                    for (int e = 0; e < 16; ++e) ss += v[e] * v[e];
                    ss += shx(ss, 1, lane); ss += shx(ss, 2, lane); ss += shx(ss, 4, lane);
                    const float r = 1.0f / sqrtf(ss * (1.f / 128.f) + EPS);
                    v4u w0, w1;
                    w0.x = pg8::cvt_pk_bf16(v[0] * r * gsc[0], v[1] * r * gsc[1]); w0.y = pg8::cvt_pk_bf16(v[2] * r * gsc[2], v[3] * r * gsc[3]);
                    w0.z = pg8::cvt_pk_bf16(v[4] * r * gsc[4], v[5] * r * gsc[5]); w0.w = pg8::cvt_pk_bf16(v[6] * r * gsc[6], v[7] * r * gsc[7]);
                    w1.x = pg8::cvt_pk_bf16(v[8] * r * gsc[8], v[9] * r * gsc[9]); w1.y = pg8::cvt_pk_bf16(v[10] * r * gsc[10], v[11] * r * gsc[11]);
                    w1.z = pg8::cvt_pk_bf16(v[12] * r * gsc[12], v[13] * r * gsc[13]); w1.w = pg8::cvt_pk_bf16(v[14] * r * gsc[14], v[15] * r * gsc[15]);
                    bf16* op = XN + (size_t)m * DM + hh * 128 + c * 16;
                    *(v4u*)op = w0; *(v4u*)(op + 8) = w1;
                }
            }
#endif
            xcd_barrier(bar);
        } else if constexpr (mixer == 1) {
            { FRESH_LANE();
            if (bx == 0) { unsigned* cz = (unsigned*)(ws + WS_CNT); for (int u_ = (int)threadIdx.x; u_ < 2048; u_ += NWAVES * 64) cz[u_] = 0u; }
            for (int it = gw; it < NB * NH * 32; it += NGW) {
                const int n = it & 31, h = (it >> 5) & 15, b = it >> 9; const int c = lane & 7, kg = lane >> 3;
                const bf16* kp = QKV + ((size_t)b * SEQ + n * 256 + kg) * 3072 + 1024 + h * 64 + c * 8;
                float a[8];
#pragma unroll
                for (int e = 0; e < 8; ++e) a[e] = 0.f;
#pragma unroll 8
                for (int i = 0; i < 32; ++i) { const bf16x8 kv = *(const bf16x8*)(kp + (size_t)i * 8 * 3072);
#pragma unroll
                    for (int e = 0; e < 8; ++e) a[e] += bf2f((unsigned short)kv[e]); }
#pragma unroll
                for (int e = 0; e < 8; ++e) { a[e] += shx(a[e], 8, lane); a[e] += shx(a[e], 16, lane); a[e] += shx(a[e], 32, lane); }
                if (kg == 0) { float* o = KM + (size_t)it * 64 + c * 8; *(f32x4*)o = (f32x4){a[0], a[1], a[2], a[3]} * (1.f / 256.f); *(f32x4*)(o + 4) = (f32x4){a[4], a[5], a[6], a[7]} * (1.f / 256.f); }
            } }
            xcd_barrier(bar);
            { FRESH_LANE();
            for (int it = gw; it < NB * NH * 128; it += NGW) {
                const int grp = it & 127, h = (it >> 7) & 15, b = it >> 11; const int own = grp >> 2;
                const int spos = grp * 64 + lane;
                const size_t tok = (size_t)b * SEQ + spos;
                const bf16* qp = QKV + tok * 3072 + h * 64;
                float q[64];
#pragma unroll
                for (int c = 0; c < 8; ++c) { const bf16x8 qv = *(const bf16x8*)(qp + c * 8);
#pragma unroll
                    for (int e = 0; e < 8; ++e) q[c * 8 + e] = bf2f((unsigned short)qv[e]); }
                float v0 = -INFINITY, v1 = -INFINITY, v2 = -INFINITY; int i0 = -1, i1 = -1, i2 = -1;
                const float* km = KM + (size_t)((b * NH + h) * 32) * 64;
                for (int n = 0; n < own; ++n) {
                    float d = 0.f;
#pragma unroll
                    for (int e = 0; e < 64; ++e) d += q[e] * km[n * 64 + e];
                    if (d > v0) { v2 = v1; i2 = i1; v1 = v0; i1 = i0; v0 = d; i0 = n; }
                    else if (d > v1) { v2 = v1; i2 = i1; v1 = d; i1 = n; }
                    else if (d > v2) { v2 = d; i2 = n; }
                }
                unsigned* cnt = (unsigned*)(ws + WS_CNT) + (b * NH + h) * 32;
                unsigned short* lst = (unsigned short*)(ws + WS_LIST) + (size_t)(b * NH + h) * 131072;
                unsigned mycnt = 0u;
                for (int n = 0; n < own; ++n) { const bool sel = (i0 == n) | (i1 == n) | (i2 == n); const unsigned long long mk = __ballot(sel); if (lane == n) mycnt = (unsigned)__popcll(mk); }
                unsigned mybase = 0u; if (mycnt) mybase = atomicAdd(cnt + lane, mycnt);
                for (int n = 0; n < own; ++n) {
                    const bool sel = (i0 == n) | (i1 == n) | (i2 == n);
                    const unsigned long long mk = __ballot(sel);
                    if (mk) {
                        const unsigned base = (unsigned)__builtin_amdgcn_readlane((int)mybase, n);
                        if (sel) { const int r = (i0 == n) ? 0 : (i1 == n) ? 1 : 2; const int rank = __popcll(mk & ((1ull << lane) - 1ull));
                            lst[256 * (31 * n - (n * (n - 1)) / 2) + base + rank] = (unsigned short)(spos | (r << 13)); }
                    }
                }
            } }
            xcd_barrier(bar);
            {
                LAS int* pre = (LAS int*)(ldsl + LDS_PRE); LAS int* tmp = (LAS int*)(ldsl + LDS_TMP); LAS int* cl = (LAS int*)(ldsl + LDS_TMP + 4096);
                const int t = (int)threadIdx.x;
                const unsigned* cnt = (const unsigned*)(ws + WS_CNT);
                int su[4], loc = 0;
#pragma unroll
                for (int k = 0; k < 4; ++k) { const unsigned cc = __hip_atomic_load(cnt + t * 4 + k, __ATOMIC_RELAXED, __HIP_MEMORY_SCOPE_AGENT); su[k] = loc; loc += (int)((cc + 255u) >> 8); cl[t * 4 + k] = (int)cc; }
                tmp[t] = loc; __syncthreads();
                for (int off = 1; off < NWAVES * 64; off <<= 1) { const int v = (t >= off) ? tmp[t - off] : 0; __syncthreads(); tmp[t] += v; __syncthreads(); }
                const int excl = tmp[t] - loc;
#pragma unroll
                for (int k = 0; k < 4; ++k) pre[t * 4 + k] = excl + su[k];
                if (t == NWAVES * 64 - 1) pre[2048] = tmp[t];
                __syncthreads();
                const int total = __builtin_amdgcn_readfirstlane(pre[2048]);
#define MOBA_UNIT(uu_, li_, k_, nv_, el_) do { int lo_ = 0, hi_ = 2047; \
                    while (lo_ < hi_) { const int mid_ = (lo_ + hi_ + 1) >> 1; const int pm_ = __builtin_amdgcn_readfirstlane(pre[mid_]); if (pm_ <= (uu_)) lo_ = mid_; else hi_ = mid_ - 1; } \
                    li_ = lo_; k_ = (uu_) - __builtin_amdgcn_readfirstlane(pre[lo_]); \
                    const int cc_ = __builtin_amdgcn_readfirstlane(cl[lo_]); \
                    nv_ = (cc_ - k_ * 256 < 256) ? (cc_ - k_ * 256) : 256; const int n_ = lo_ & 31; \
                    el_ = (const unsigned short*)(ws + WS_LIST) + (size_t)(lo_ >> 5) * 131072 + 256 * (31 * n_ - (n_ * (n_ - 1)) / 2) + k_ * 256; } while (0)
                int tq_ = (int)threadIdx.x; asm volatile("" : "+v"(tq_)); const int ri = (tq_ >> 6) * 32 + (tq_ & 31);
                int uu = vcu;
                if (uu < total) {
                    int li, k, nv; const unsigned short* el; MOBA_UNIT(uu, li, k, nv, el);
                    unsigned ent = (ri < nv) ? (unsigned)el[ri] : 0u;
                    for (;;) {
                        const int un = uu + G; const bool has = un < total;
                        int li2 = 0, k2 = 0, nv2 = 0; const unsigned short* el2 = el; unsigned ent2 = 0u;
                        if (has) { MOBA_UNIT(un, li2, k2, nv2, el2); ent2 = (ri < nv2) ? (unsigned)el2[ri] : 0u; }
                        const int n = li & 31, h = (li >> 5) & 15, b = li >> 9;
                        const size_t r0 = (size_t)b * SEQ;
                        attn_body::SpArgs sp{};
                        sp.el = el; sp.nvalid = nv; sp.nsel = 0; sp.h = h; sp.tok0 = (long)r0;
                        sp.d0 = (attn_body::bf16*)XN; sp.d1 = (attn_body::bf16*)hbuf; sp.d2 = ((attn_body::bf16*)hbuf + (size_t)T * 1024); sp.lse = (float*)(ws + WS_LSE);
#ifndef NO_A1
                        attn_body::attn_unit<4, 8>((const attn_body::bf16*)(QKV + r0 * 3072 + h * 64), (const attn_body::bf16*)(QKV + (r0 + n * 256) * 3072 + 1024 + h * 64),
                            (const attn_body::bf16*)(QKV + (r0 + n * 256) * 3072 + 2048 + h * 64), nullptr, 4, nullptr, 0.f, (char*)lds, sp, ent);
#endif
                        if (!has) break;
                        uu = un; li = li2; k = k2; nv = nv2; el = el2; ent = ent2;
                    }
                }
#undef MOBA_UNIT
            }
            xcd_barrier(bar);
            for (int uu = vcu; uu < NB * NH * 32; uu += G) {
                const int qb = uu & 31, h = (uu >> 5) & 15, b = uu >> 9;
                const size_t r0 = (size_t)b * SEQ, q0 = (size_t)qb * 256;
                attn_body::SpArgs sp{};
                sp.el = nullptr; sp.nvalid = 256; sp.nsel = qb < 3 ? qb : 3; sp.h = h; sp.tok0 = (long)(r0 + q0);
                sp.d0 = (attn_body::bf16*)XN; sp.d1 = (attn_body::bf16*)hbuf; sp.d2 = ((attn_body::bf16*)hbuf + (size_t)T * 1024); sp.lse = (float*)(ws + WS_LSE);
#ifndef NO_A1
                attn_body::attn_unit<5, 8>((const attn_body::bf16*)(QKV + (r0 + q0) * 3072 + h * 64), (const attn_body::bf16*)(QKV + (r0 + q0) * 3072 + 1024 + h * 64),
                    (const attn_body::bf16*)(QKV + (r0 + q0) * 3072 + 2048 + h * 64), nullptr, 4, nullptr, 0.f, (char*)lds, sp);
#endif
            }
            xcd_barrier(bar);
        } else {
            for (int u = vcu; u < NB * 2 * 64 * 4; u += G) {
                const int p = u & 3, qk = (u >> 2) & 63, kvh = (u >> 8) & 1, b = u >> 9, h = kvh * 8 + 2 * p;
                const size_t r0 = (size_t)b * SEQ, q0 = (size_t)qk * 128, k0 = qk > 0 ? q0 - 128 : 0;
                attn_body::SpArgs sp{}; sp.nsel = qk > 0 ? 2 : 0;
#ifndef NO_A2
                attn_body::attn_unit<6, 8>((const attn_body::bf16*)(QKV + (r0 + q0) * 1280 + h * 64), (const attn_body::bf16*)(QKV + (r0 + k0) * 1280 + 1024 + kvh * 64),
                    (const attn_body::bf16*)(QKV + (r0 + k0) * 1280 + 1152 + kvh * 64), (attn_body::bf16*)(XN + (r0 + q0) * 1024 + h * 64), 4, (const unsigned*)(ARGS_IN(15) + h), 0.f, (char*)lds, sp);
#endif
            }
            xcd_barrier(bar);
        }
        {
            pg8::Gemm g{XN, Wout, T, DM, DM}; pg8::StaticOrder S; S.init(T, DM, G, bx);
            pg8::EpiRes<L == 0> E{XIN, HB, DM, RSQ};
            pg8::gemm_phase<pg8::EpiRes<L == 0>, pg8::StaticOrder, true, true>(ldsl, g, S, E);
        }
        xcd_barrier(bar);
        {
            pg8::Gemm g{HB, Wup, T, DFF, DM}; pg8::StaticOrder S; S.init(T, DFF, G, bx);
            pg8::EpiRelu2 E{U, DFF, RSQ};
            pg8::gemm_phase<pg8::EpiRelu2, pg8::StaticOrder, true, true>(ldsl, g, S, E);
        }
        xcd_barrier(bar);
        {
            pg8::Gemm g{U, Wdown, T, DM, DFF}; pg8::StaticOrder S; S.init(T, DM, G, bx);
            pg8::EpiRes<false> E{nullptr, HB, DM, RSQ};
            pg8::gemm_phase<pg8::EpiRes<false>, pg8::StaticOrder, true, true>(ldsl, g, S, E);
        }
        xcd_barrier(bar);
        if (L + 1 == DEPTH) { FRESH_LANE(); for (int m = gw; m < T; m += 2 * NGW) rms_rowb2_to_f32(HB + (size_t)m * DM, HB + (size_t)(m + NGW) * DM, ARGS_IN(19), hbuf + (size_t)m * DM, hbuf + (size_t)(m + NGW) * DM, lane); }
    }
}
#undef FRESH_LANE
#undef ARGS_IN
#undef ws
#undef XIN
#undef hbuf
#undef ROPE
#undef SEL
#undef KM
#undef XN
#undef QKV
#undef O2
#undef U
#undef HB
#undef RSQ
#undef Win
#undef Wout
#undef Wup
#undef Wdown

__global__ void __launch_bounds__(NWAVES * 64, 2) fwd_mega(Args args) {
    extern __shared__ __attribute__((aligned(16))) unsigned char lds[];
    cg::grid_group grid = cg::this_grid();
    int tid_ = threadIdx.x; asm volatile("" : "+v"(tid_)); const int tid = tid_, lane = tid & 63, wave = __builtin_amdgcn_readfirstlane(tid >> 6);
    const int G = gridDim.x, bx = blockIdx.x;
    const int vcu = (G % 8 == 0) ? (bx % 8) * (G / 8) + bx / 8 : bx;
    const int gw = vcu * NWAVES + wave, NGW = G * NWAVES;
    unsigned char* ws = args.ws;
    const float* x = args.in[0]; const int* positions = (const int*)args.in[1];
    float* hbuf = args.out;
    float* ROPE = (float*)(ws + WS_ROPE); unsigned* SEL = (unsigned*)(ws + WS_SEL); float* KM = (float*)(ws + WS_KM);
    bf16* XN = (bf16*)(ws + WS_XN); bf16* QKV = (bf16*)(ws + WS_QKV); bf16* O2 = (bf16*)(ws + WS_O2); bf16* U = (bf16*)(ws + WS_U);
    LAS unsigned char* ldsl = (LAS unsigned char*)lds;
    if (tid < 64) ((LAS unsigned*)(ldsl + LDSCTL_OFF))[tid] = 0u;
    unsigned* barw = (unsigned*)(ws + WS_CTL);
    __syncthreads();
    const XcdBarrier bar = xcd_barrier_post(barw, (volatile LAS unsigned*)(ldsl + LDSCTL_OFF + 32));

#ifndef NO_PRO
    {
        LAS float* scr = (LAS float*)(ldsl + wave * 16384);
        int base = 0;
#pragma unroll 1
        for (int id = 0; id < 16; ++id) {
            const int L = id >> 2, kind = id & 3;
            const float* W; const float* gk = nullptr; int K, N; size_t off;
            if (kind == 0) { K = DM; off = W_IN; gk = args.in[2] + L * DM;
                if (L == 1) { W = args.in[11]; N = 3072; } else if (L == 2) { W = args.in[13]; N = 1280; } else { W = args.in[4] + (size_t)(L == 3 ? 1 : 0) * DM * 3072; N = 3072; } }
            else if (kind == 1) { K = DM; N = DM; off = W_OUT;
                if (L == 1) W = args.in[12]; else if (L == 2) W = args.in[16]; else W = args.in[5] + (size_t)(L == 3 ? 1 : 0) * DM * DM; }
            else if (kind == 2) { K = DM; N = DFF; off = W_UP; W = args.in[17] + (size_t)L * DM * DFF; gk = args.in[3] + L * DM; }
            else { K = DFF; N = DM; off = W_DOWN; W = args.in[18] + (size_t)L * DFF * DM; }
            bf16* WT = (bf16*)(ws + WS_W + (size_t)L * W_LAYER + off);
            const int items = (K / 64) * (N / 32);
            int it = (gw - base) % NGW; if (it < 0) it += NGW;
            for (; it < items; it += NGW) transpose_item(W, gk, K, N, WT, scr, it, lane);
            base = (base + items) % NGW;
        }
        for (int idx = bx * (NWAVES * 64) + tid; idx < T * 8; idx += G * NWAVES * 64) {
            const int tok = idx >> 3, i = idx & 7;
            const float inv = exp2f(-(float)i * (0.125f * 18.931568569324174f));
            const double a = (double)((float)positions[tok] * inv);
            const double k = rint(a * 0.15915494309189535);
            const float r = (float)(a - k * 6.283185307179586);
            ROPE[(size_t)tok * 16 + i] = cosf(r); ROPE[(size_t)tok * 16 + 8 + i] = sinf(r);
        }
        for (int m = gw; m < T; m += NGW) row_to_bf16_sumsq(x + (size_t)m * DM, (bf16*)(ws + WS_HB) + (size_t)m * DM, (float*)(ws + WS_RSQ) + (size_t)m * 16, lane);
    }
#endif
    if (args.out == nullptr) grid.sync();
    xcd_barrier(bar);

    layer_fwd<0>(lds, bar); layer_fwd<1>(lds, bar); layer_fwd<2>(lds, bar); layer_fwd<3>(lds, bar);
}

extern "C" void kernel_launch(void* const* d_in, const int* in_sizes, int n_in, void* d_out, int out_size, void* d_ws, size_t ws_size, hipStream_t stream) {
    static int grid = 0;
    if (grid == 0) {
        int dev = 0, cus = 0, per_cu = 0;
        if (n_in != 20 || out_size != T * DM || ws_size < WS_END) { fprintf(stderr, "kernel_launch: unexpected problem (n_in %d out %d ws %zu)\n", n_in, out_size, ws_size); grid = -1; return; }
        (void)hipGetDevice(&dev);
        (void)hipDeviceGetAttribute(&cus, hipDeviceAttributeMultiprocessorCount, dev);
        (void)hipFuncSetAttribute((const void*)fwd_mega, hipFuncAttributeMaxDynamicSharedMemorySize, LDS_BYTES);
        (void)hipOccupancyMaxActiveBlocksPerMultiprocessor(&per_cu, (const void*)fwd_mega, NWAVES * 64, LDS_BYTES);
        (void)hipGetLastError();
        grid = cus;
    }
    if (grid < 0) return;
    Args a{};
    for (int i = 0; i < 20; ++i) a.in[i] = (const float*)d_in[i];
    a.out = (float*)d_out; a.ws = (unsigned char*)d_ws;
    void* kargs[] = {&a};
    (void)hipMemsetAsync((unsigned char*)d_ws + WS_CTL, 0, 16384, stream);
    hipError_t e = hipLaunchCooperativeKernel((void*)fwd_mega, dim3(grid), dim3(NWAVES * 64), kargs, LDS_BYTES, stream);
    if (e != hipSuccess) fprintf(stderr, "cooperative launch failed: %s (grid %d)\n", hipGetErrorString(e), grid);
}
```
